# Optimizing an MI355X kernel written in HIP

```python
import math
import jax, jax.numpy as jnp
from jax import lax
import numpy as np

D_MODEL = 1024
BATCH = 8
SEQ = 2048
DEPTH = 1

LRU_WIDTH = D_MODEL
LRU_BLOCKS = 16
LRU_BLOCK_W = LRU_WIDTH // LRU_BLOCKS
CONV_WIDTH = 4
LRU_C = 8.0
HEAD_DIM = 64
N_Q_HEADS = 16
N_KV_HEADS = 2
GQA_GROUP = N_Q_HEADS // N_KV_HEADS
ATTN_WIDTH = N_Q_HEADS * HEAD_DIM
KV_WIDTH = N_KV_HEADS * HEAD_DIM
WINDOW = 128
BLOCK = 128
IN_WIDTH = 2 * LRU_WIDTH + ATTN_WIDTH + 2 * KV_WIDTH
MIX_WIDTH = LRU_WIDTH + ATTN_WIDTH
D_FF = 4 * D_MODEL
EPS = 1e-6
NEG_INF = -1e30

kernel_name = "hymba_rglru_swa_sink_hybrid"


def rmsnorm(x, g):
    x32 = x.astype(jnp.float32)
    y = x32 * lax.rsqrt(jnp.mean(x32 * x32, axis=-1, keepdims=True) + EPS)
    return (y * g.astype(jnp.float32)).astype(x.dtype)


def causal_depthwise_conv(x, w, b):
    t = x.shape[1]
    xp = jnp.pad(x, ((0, 0), (CONV_WIDTH - 1, 0), (0, 0)))
    y = sum(w[k] * xp[:, k:k + t] for k in range(CONV_WIDTH))
    return y + b


def rg_lru(x, w_a, b_a, w_x, b_x, lam):
    bsz, t, _ = x.shape
    xb = x.reshape(bsz, t, LRU_BLOCKS, LRU_BLOCK_W)
    gate_r = jax.nn.sigmoid(jnp.einsum('btnc,ncd->btnd', xb, w_a).reshape(bsz, t, LRU_WIDTH) + b_a)
    gate_i = jax.nn.sigmoid(jnp.einsum('btnc,ncd->btnd', xb, w_x).reshape(bsz, t, LRU_WIDTH) + b_x)
    r32 = gate_r.astype(jnp.float32)
    log_a = -LRU_C * r32 * jax.nn.softplus(-lam.astype(jnp.float32))
    a = jnp.exp(log_a)
    mult = jnp.sqrt(-jnp.expm1(2.0 * log_a))
    bterm = mult * (gate_i * x).astype(jnp.float32)

    def combine(lhs, rhs):
        a_l, b_l = lhs
        a_r, b_r = rhs
        return a_l * a_r, a_r * b_l + b_r

    _, h = lax.associative_scan(combine, (a, bterm), axis=1)
    return h.astype(x.dtype)


def sliding_window_sink_attention(q, k, v, sinks):
    bsz, t, _ = q.shape
    nb = t // BLOCK
    qb = q.reshape(bsz, nb, BLOCK, N_KV_HEADS, GQA_GROUP, HEAD_DIM)
    kb = k.reshape(bsz, nb, BLOCK, N_KV_HEADS, HEAD_DIM)
    vb = v.reshape(bsz, nb, BLOCK, N_KV_HEADS, HEAD_DIM)
    zero_blk = jnp.zeros_like(kb[:, :1])
    kp = jnp.concatenate([zero_blk, kb], axis=1)
    vp = jnp.concatenate([zero_blk, vb], axis=1)
    kwin = jnp.concatenate([kp[:, :-1], kp[:, 1:]], axis=2)
    vwin = jnp.concatenate([vp[:, :-1], vp[:, 1:]], axis=2)

    scale = 1.0 / math.sqrt(HEAD_DIM)
    scores = jnp.einsum('bnqhgd,bnkhd->bnhgqk', qb, kwin).astype(jnp.float32) * scale
    blk = jnp.arange(nb)[:, None, None]
    qpos = blk * BLOCK + jnp.arange(BLOCK)[None, :, None]
    kpos = (blk - 1) * BLOCK + jnp.arange(2 * BLOCK)[None, None, :]
    mask = (kpos <= qpos) & (kpos > qpos - WINDOW) & (kpos >= 0)
    scores = jnp.where(mask[None, :, None, None], scores, NEG_INF)

    sink = sinks.astype(jnp.float32).reshape(1, 1, N_KV_HEADS, GQA_GROUP, 1, 1)
    m = jnp.maximum(jnp.max(scores, axis=-1, keepdims=True), sink)
    p = jnp.exp(scores - m)
    denom = jnp.sum(p, axis=-1, keepdims=True) + jnp.exp(sink - m)
    probs = (p / denom).astype(v.dtype)
    out = jnp.einsum('bnhgqk,bnkhd->bnqhgd', probs, vwin)
    return out.reshape(bsz, t, ATTN_WIDTH)


def setup_inputs(seed: int = 0) -> dict:
    key = jax.random.key(seed)
    ks = jax.random.split(key, 24)
    f32 = jnp.float32

    def nrm(k, shape, scale):
        return jax.random.normal(k, shape, f32) * scale

    def gain(k, n):
        return jnp.ones((DEPTH, n), f32) + 0.02 * jax.random.normal(k, (DEPTH, n), f32)

    x = jax.random.normal(ks[0], (BATCH, SEQ, D_MODEL), f32)
    base = jax.random.uniform(ks[9], (DEPTH, LRU_WIDTH), f32, minval=0.9, maxval=0.999)
    s = base ** (1.0 / LRU_C)
    lru_lambda = jnp.log(s) - jnp.log1p(-s)
    return {
        "x": x,
        "norm_mix_g": gain(ks[1], D_MODEL),
        "w_in": nrm(ks[2], (DEPTH, D_MODEL, IN_WIDTH), D_MODEL ** -0.5),
        "conv_w": nrm(ks[3], (DEPTH, CONV_WIDTH, LRU_WIDTH), CONV_WIDTH ** -0.5),
        "conv_b": nrm(ks[4], (DEPTH, LRU_WIDTH), 0.02),
        "w_gate_a": nrm(ks[5], (DEPTH, LRU_BLOCKS, LRU_BLOCK_W, LRU_BLOCK_W), LRU_BLOCK_W ** -0.5),
        "b_gate_a": nrm(ks[6], (DEPTH, LRU_WIDTH), 0.02),
        "w_gate_x": nrm(ks[7], (DEPTH, LRU_BLOCKS, LRU_BLOCK_W, LRU_BLOCK_W), LRU_BLOCK_W ** -0.5),
        "b_gate_x": nrm(ks[8], (DEPTH, LRU_WIDTH), 0.02),
        "lru_lambda": lru_lambda,
        "attn_sinks": nrm(ks[10], (DEPTH, N_Q_HEADS), 0.5),
        "lru_out_g": gain(ks[11], LRU_WIDTH),
        "attn_out_g": gain(ks[12], ATTN_WIDTH),
        "w_out": nrm(ks[13], (DEPTH, MIX_WIDTH, D_MODEL), MIX_WIDTH ** -0.5),
        "norm_mlp_g": gain(ks[14], D_MODEL),
        "w_mlp_up": nrm(ks[15], (DEPTH, D_MODEL, D_FF), D_MODEL ** -0.5),
        "w_mlp_down": nrm(ks[16], (DEPTH, D_FF, D_MODEL), D_FF ** -0.5),
        "norm_final_g": jnp.ones((D_MODEL,), f32) + 0.02 * jax.random.normal(ks[17], (D_MODEL,), f32),
    }


def reference(x, norm_mix_g, w_in, conv_w, conv_b, w_gate_a, b_gate_a, w_gate_x, b_gate_x,
              lru_lambda, attn_sinks, lru_out_g, attn_out_g, w_out, norm_mlp_g,
              w_mlp_up, w_mlp_down, norm_final_g):
    s1 = LRU_WIDTH
    s2 = 2 * LRU_WIDTH
    s3 = s2 + ATTN_WIDTH
    s4 = s3 + KV_WIDTH
    for l in range(DEPTH):
        hn = rmsnorm(x, norm_mix_g[l])
        proj = jnp.einsum('btd,de->bte', hn, w_in[l])
        x_lru = proj[..., :s1]
        g_lru = proj[..., s1:s2]
        q = proj[..., s2:s3]
        k = proj[..., s3:s4]
        v = proj[..., s4:]

        xc = causal_depthwise_conv(x_lru, conv_w[l], conv_b[l])
        h = rg_lru(xc, w_gate_a[l], b_gate_a[l], w_gate_x[l], b_gate_x[l], lru_lambda[l])
        y_lru = h * jax.nn.gelu(g_lru, approximate=True)

        y_attn = sliding_window_sink_attention(q, k, v, attn_sinks[l])

        mixed = jnp.concatenate([rmsnorm(y_lru, lru_out_g[l]),
                                 rmsnorm(y_attn, attn_out_g[l])], axis=-1)
        x = x + jnp.einsum('bte,ed->btd', mixed, w_out[l])

        hm = rmsnorm(x, norm_mlp_g[l])
        up = jnp.einsum('btd,df->btf', hm, w_mlp_up[l])
        x = x + jnp.einsum('btf,fd->btd', jnp.square(jax.nn.relu(up)), w_mlp_down[l])
    return rmsnorm(x, norm_final_g)
```

```cpp
#include <hip/hip_runtime.h>
#include <hip/hip_cooperative_groups.h>
#include <cstdio>
#include <cstdint>
namespace cg = cooperative_groups;
namespace pg8 {
#define PG8_LAS __attribute__((address_space(3)))
typedef unsigned short bf16_t;
typedef short bf16x8 __attribute__((ext_vector_type(8)));
typedef float f32x4 __attribute__((ext_vector_type(4)));
typedef unsigned u32x4 __attribute__((ext_vector_type(4)));
constexpr int BM = 256, BK = 64, HALF = 128, HTB = HALF * BK * 2  , STAGE_BYTES = 8 * HTB, NXCD = 8, WGM = 8;

__host__ __device__ __forceinline__ int lds_byte(int r, int c) { const int st = (r >> 4) * 2 + (c >> 5), rr = r & 15, cc = c & 31, ob = rr * 64 + cc * 2; return st * 1024 + (ob ^ (((ob >> 9) & 1) << 5)); }
__host__ __device__ __forceinline__ void stage_rc(int b, int& R, int& C) { const int st = b / 1024, sb = b % 1024, swz = sb ^ (((sb >> 9) & 1) << 5); R = (st >> 1) * 16 + swz / 64; C = (st & 1) * 32 + (swz % 64) / 2; }
__host__ __device__ __forceinline__ int perm32(int rho) { const int n = rho >> 4, i = rho & 15; return 8 * (i >> 2) + 4 * n + (i & 3); }

struct Unit { int pm, pn; };
struct Gemm { const bf16_t* A; const bf16_t* Bt; int M, N, K; };

struct StaticOrder {
    int nM, nN, nwg, G, c;
    __host__ __device__ void init(int M, int N, int G_, int c_) { nM = M / BM; nN = N / BM; nwg = nM * nN; G = G_; c = c_; }
    __host__ __device__ bool next(int i, Unit& u) const {
        const long L = (long)i * G + c; if (L >= nwg) return false;
        int wgid = (int)L; { const int q = nwg / NXCD, r = nwg % NXCD, xcd = wgid % NXCD, off = wgid / NXCD; wgid = (xcd < r ? xcd * (q + 1) : r * (q + 1) + (xcd - r) * q) + off; }
        const int nig = WGM * nN, gid = wgid / nig, fm = gid * WGM, gsz = (nM - fm) < WGM ? (nM - fm) : WGM;
        u.pm = fm + ((wgid % nig) % gsz); u.pn = (wgid % nig) / gsz; return true;
    }
    __device__ __forceinline__ void a_ready(const Unit&) const {}
    __device__ __forceinline__ void done(const Unit&) const {}
};

__device__ __forceinline__ unsigned cvt_pk_bf16(float lo, float hi) { unsigned r; asm volatile("v_cvt_pk_bf16_f32 %0, %1, %2" : "=v"(r) : "v"(lo), "v"(hi)); return r; }
typedef float f32x2 __attribute__((ext_vector_type(2)));
constexpr float RMS_EPS = 1e-6f;
__device__ __forceinline__ u32x4 pack8(f32x4 v0, f32x4 v1) { u32x4 w; w.x = cvt_pk_bf16(v0[0], v0[1]); w.y = cvt_pk_bf16(v0[2], v0[3]); w.z = cvt_pk_bf16(v1[0], v1[1]); w.w = cvt_pk_bf16(v1[2], v1[3]); return w; }

struct EpiProj {
    static constexpr bool PERM = true, AFTER_DRAIN = false, MIDK = false;
    bf16_t* O; int ldc; float qscale;
    __device__ __forceinline__ void midk(f32x4 (&)[2][2][4][2], int, int) const {}
    __device__ __forceinline__ void operator()(const f32x4 (&acc)[2][2][4][2], const Unit& u, int wr, int wc, int fr, int fq) const {
        const int row0 = u.pm * BM + wr * 64 + fr, col0 = u.pn * BM + wc * 32 + 8 * fq;
        const float sc = (u.pn >= 8 && u.pn < 12) ? qscale : 1.f;
#pragma unroll
        for (int ai = 0; ai < 2; ++ai)
#pragma unroll
            for (int m = 0; m < 4; ++m) { bf16_t* rowp = O + (size_t)(row0 + ai * HALF + m * 16) * ldc + col0;
#pragma unroll
                for (int bj = 0; bj < 2; ++bj) *(u32x4*)(rowp + bj * HALF) = pack8(acc[ai][bj][m][0] * sc, acc[ai][bj][m][1] * sc); }
    }
};
struct EpiUp {
    static constexpr bool PERM = true, AFTER_DRAIN = false, MIDK = false;
    bf16_t* O; int ldc; const float* ssq;
    __device__ __forceinline__ void midk(f32x4 (&)[2][2][4][2], int, int) const {}
    __device__ __forceinline__ void operator()(const f32x4 (&acc)[2][2][4][2], const Unit& u, int wr, int wc, int fr, int fq) const {
        const int row0 = u.pm * BM + wr * 64 + fr, col0 = u.pn * BM + wc * 32 + 8 * fq;
#pragma unroll
        for (int ai = 0; ai < 2; ++ai)
#pragma unroll
            for (int m = 0; m < 4; ++m) { const int row = row0 + ai * HALF + m * 16; const f32x4 p = *(const f32x4*)(ssq + (size_t)row * 4);
                const float rs = __builtin_amdgcn_rsqf(((p[0] + p[1]) + (p[2] + p[3])) * (1.0f / 1024.0f) + RMS_EPS);
                bf16_t* rowp = O + (size_t)row * ldc + col0;
#pragma unroll
                for (int bj = 0; bj < 2; ++bj) { f32x4 v0 = acc[ai][bj][m][0] * rs, v1 = acc[ai][bj][m][1] * rs;
#pragma unroll
                    for (int e = 0; e < 4; ++e) { const float a = fmaxf(v0[e], 0.f), b = fmaxf(v1[e], 0.f); v0[e] = a * a; v1[e] = b * b; }
                    *(u32x4*)(rowp + bj * HALF) = pack8(v0, v1); } }
    }
};
template <bool HAS_MIDK, bool HAS_B16> struct EpiRes {
    static constexpr bool PERM = true, AFTER_DRAIN = true, MIDK = HAS_MIDK;
    const float* base; float* out; bf16_t* ob; float* ssq; const PG8_LAS float* ratio; const PG8_LAS float* rsl;
    __device__ __forceinline__ void midk(f32x4 (&acc)[2][2][4][2], int wr, int fr) const {
#pragma unroll
        for (int ai = 0; ai < 2; ++ai)
#pragma unroll
            for (int m = 0; m < 4; ++m) { const float f = ratio[ai * HALF + wr * 64 + m * 16 + fr];
#pragma unroll
                for (int bj = 0; bj < 2; ++bj) { acc[ai][bj][m][0] = acc[ai][bj][m][0] * f; acc[ai][bj][m][1] = acc[ai][bj][m][1] * f; } }
    }
    __device__ __forceinline__ void fused(f32x4 (&acc)[2][2][4][2], const Unit& u, int wr, int wc, int fr, int fq, PG8_LAS unsigned char* lds, int wid, int lane) const {
        PG8_LAS float* P = (PG8_LAS float*)lds;
#pragma unroll
        for (int ai = 0; ai < 2; ++ai)
#pragma unroll
            for (int m = 0; m < 4; ++m) { const int r = ai * HALF + wr * 64 + m * 16 + fr; const size_t row = (size_t)u.pm * BM + r;
                const float rs = HAS_MIDK ? rsl[r] : 1.f; float s = 0.f;
#pragma unroll
                for (int bj = 0; bj < 2; ++bj) { const size_t off = row * 1024 + u.pn * BM + bj * HALF + wc * 32 + 8 * fq;
                    const f32x4 xa = *(const f32x4*)(base + off), xb = *(const f32x4*)(base + off + 4);
                    const f32x4 v0 = xa + acc[ai][bj][m][0] * rs, v1 = xb + acc[ai][bj][m][1] * rs;
                    *(f32x4*)(out + off) = v0; *(f32x4*)(out + off + 4) = v1;
                    if (HAS_B16) *(u32x4*)(ob + off) = pack8(v0, v1);
                    s += (v0[0] * v0[0] + v0[1] * v0[1]) + (v0[2] * v0[2] + v0[3] * v0[3]) + (v1[0] * v1[0] + v1[1] * v1[1]) + (v1[2] * v1[2] + v1[3] * v1[3]); }
                s += __shfl_xor(s, 16); s += __shfl_xor(s, 32);
                if (fq == 0) P[r * 4 + wc] = s; }
        __syncthreads();
        const int t = wid * 64 + lane;
        if (t < 256) { const float s = (P[t * 4] + P[t * 4 + 1]) + (P[t * 4 + 2] + P[t * 4 + 3]); ssq[((size_t)u.pm * BM + t) * 4 + u.pn] = s; }
    }
};

template <class Epi, class Sched, bool ALIGN_EPI = false, bool SP2 = false>
__device__ __forceinline__ void gemm_phase(PG8_LAS unsigned char* lds, const Gemm g, const Sched& S, const Epi& E) {
    const int tid = threadIdx.x, wid = __builtin_amdgcn_readfirstlane(tid >> 6), lane = tid & 63, wr = wid >> 2, wc = wid & 3, fr = lane & 15, fq = lane >> 4;
    const int K = g.K, nt = K / BK;
    unsigned voffA[2], voffB[2];
#pragma unroll
    for (int i = 0; i < 2; ++i) { int R, C; stage_rc(tid * 16 + i * 8192, R, C); const int Rb = Epi::PERM ? ((R & ~31) + perm32(R & 31)) : R;
        voffA[i] = (unsigned)(R * K + C) * 2u; voffB[i] = (unsigned)(Rb * K + C) * 2u; }
    const size_t kstep = (size_t)(BK * 2);
    const size_t hstep = (size_t)HALF * K * 2;
    const size_t tstep = 2 * hstep;
    const unsigned ldsw = (unsigned)wid * 1024u;
    const int aoff = lds_byte(wr * 64 + fr, fq * 8), boff = lds_byte(wc * 32 + fr, fq * 8);
#define PG8_SA(b, h) (((b) * 2 + (h)) * HTB)
#define PG8_SB(b, h) ((4 + (b) * 2 + (h)) * HTB)
#define PG8_STAGE(bufoff, gbase, voff) do { _Pragma("unroll") for (int _i = 0; _i < 2; ++_i) \
        __builtin_amdgcn_global_load_lds((const unsigned*)((const char*)(gbase) + (voff)[_i]), (PG8_LAS unsigned*)(lds + (bufoff) + ldsw + _i * 8192), 16, 0, 0); } while (0)
#define PG8_LDA(dst, b, h) do { _Pragma("unroll") for (int m = 0; m < 4; ++m) _Pragma("unroll") for (int k = 0; k < 2; ++k) dst[m][k] = *(const PG8_LAS bf16x8*)(lds + PG8_SA(b, h) + aoff + m * 2048 + k * 1024); } while (0)
#define PG8_LDB(dst, b, h) do { _Pragma("unroll") for (int n = 0; n < 2; ++n) _Pragma("unroll") for (int k = 0; k < 2; ++k) dst[n][k] = *(const PG8_LAS bf16x8*)(lds + PG8_SB(b, h) + boff + n * 2048 + k * 1024); } while (0)
#define PG8_MMA(ai, bj, At, Bt) do { __builtin_amdgcn_s_setprio(1); _Pragma("unroll") for (int m = 0; m < 4; ++m) _Pragma("unroll") for (int n = 0; n < 2; ++n) _Pragma("unroll") for (int k = 0; k < 2; ++k) \
        acc[ai][bj][m][n] = __builtin_amdgcn_mfma_f32_16x16x32_bf16(Bt[n][k], At[m][k], acc[ai][bj][m][n], 0, 0, 0); __builtin_amdgcn_s_setprio(0); } while (0)
#define PG8_WAIT_V(n) asm volatile("s_waitcnt vmcnt(" #n ")" ::: "memory")
#define PG8_WAIT_L(n) asm volatile("s_waitcnt lgkmcnt(" #n ")" ::: "memory")
#define PG8_BAR __builtin_amdgcn_s_barrier()
#define PG8_SCHED __builtin_amdgcn_sched_barrier(0)
    Unit cur, nxt; int ui = 0;
    if (!S.next(0, cur)) return;
    f32x4 acc[2][2][4][2];
#pragma unroll
    for (int a = 0; a < 2; ++a)
#pragma unroll
        for (int b = 0; b < 2; ++b)
#pragma unroll
            for (int m = 0; m < 4; ++m)
#pragma unroll
                for (int n = 0; n < 2; ++n) acc[a][b][m][n] = (f32x4){0.f, 0.f, 0.f, 0.f};
    bf16x8 At[4][2], B0[2][2], B1[2][2];
    const char* cA = (const char*)g.A + (size_t)cur.pm * tstep; const char* cB = (const char*)g.Bt + (size_t)cur.pn * tstep;
    S.a_ready(cur);
    if constexpr (SP2) {
        PG8_STAGE(PG8_SB(0, 0), cB, voffB); PG8_STAGE(PG8_SB(0, 1), cB + hstep, voffB); PG8_STAGE(PG8_SA(0, 0), cA, voffA); PG8_STAGE(PG8_SA(0, 1), cA + hstep, voffA);
        if (wr == 1) PG8_BAR;
        PG8_WAIT_V(2); PG8_BAR;
        PG8_STAGE(PG8_SB(1, 0), cB + kstep, voffB); PG8_STAGE(PG8_SA(1, 0), cA + kstep, voffA); PG8_STAGE(PG8_SB(1, 1), cB + hstep + kstep, voffB);
        PG8_WAIT_V(6); PG8_BAR;
    } else {
        PG8_STAGE(PG8_SB(0, 0), cB, voffB); PG8_STAGE(PG8_SA(0, 0), cA, voffA); PG8_STAGE(PG8_SB(0, 1), cB + hstep, voffB); PG8_STAGE(PG8_SA(0, 1), cA + hstep, voffA);
        if (wr == 1) PG8_BAR;
        PG8_WAIT_V(4); PG8_BAR;
        PG8_STAGE(PG8_SB(1, 0), cB + kstep, voffB); PG8_STAGE(PG8_SA(1, 0), cA + kstep, voffA); PG8_STAGE(PG8_SB(1, 1), cB + hstep + kstep, voffB);
        PG8_WAIT_V(6); PG8_BAR;
    }
    for (;;) {
        const bool has_next = S.next(ui + 1, nxt);
        const char* nA = has_next ? (const char*)g.A + (size_t)nxt.pm * tstep : cA; const char* nB = has_next ? (const char*)g.Bt + (size_t)nxt.pn * tstep : cB;
        for (int t = 0; t < nt; t += 2) {
            const bool last = (t == nt - 2);
            const char* a1 = cA + (size_t)(t + 1) * kstep;
            const char* a2 = last ? nA : cA + (size_t)(t + 2) * kstep; const char* b2 = last ? nB : cB + (size_t)(t + 2) * kstep;
            const char* a3 = a2 + kstep; const char* b3 = b2 + kstep;
            if (last && has_next) S.a_ready(nxt);
            if constexpr (Epi::MIDK) { if (t == nt / 2) E.midk(acc, wr, fr); }
            if constexpr (SP2) {
            PG8_LDB(B0, 0, 0); PG8_LDB(B1, 0, 1); PG8_SCHED; PG8_LDA(At, 0, 0); PG8_STAGE(PG8_SA(1, 1), a1 + hstep, voffA);
            PG8_WAIT_V(8); PG8_WAIT_L(0); PG8_BAR; PG8_MMA(0, 0, At, B0); PG8_MMA(0, 1, At, B1); PG8_BAR; PG8_SCHED;
            PG8_LDA(At, 0, 1); PG8_STAGE(PG8_SB(0, 0), b2, voffB); PG8_STAGE(PG8_SB(0, 1), b2 + hstep, voffB); PG8_STAGE(PG8_SA(0, 0), a2, voffA);
            PG8_WAIT_V(8); PG8_WAIT_L(0); PG8_BAR; PG8_MMA(1, 0, At, B0); PG8_MMA(1, 1, At, B1); PG8_BAR; PG8_SCHED;
            PG8_LDB(B0, 1, 0); PG8_LDB(B1, 1, 1); PG8_SCHED; PG8_LDA(At, 1, 0); PG8_STAGE(PG8_SA(0, 1), a2 + hstep, voffA);
            PG8_WAIT_V(8); PG8_WAIT_L(0); PG8_BAR; PG8_MMA(0, 0, At, B0); PG8_MMA(0, 1, At, B1); PG8_BAR; PG8_SCHED;
            PG8_LDA(At, 1, 1); PG8_STAGE(PG8_SB(1, 0), b3, voffB); PG8_STAGE(PG8_SB(1, 1), b3 + hstep, voffB); PG8_STAGE(PG8_SA(1, 0), a3, voffA);
            PG8_WAIT_V(8); PG8_WAIT_L(0); PG8_BAR; PG8_MMA(1, 0, At, B0); PG8_MMA(1, 1, At, B1); PG8_BAR; PG8_SCHED;
            } else {
            PG8_LDB(B0, 0, 0); PG8_SCHED; PG8_LDA(At, 0, 0); PG8_STAGE(PG8_SA(1, 1), a1 + hstep, voffA);
            PG8_WAIT_L(8); PG8_BAR; PG8_WAIT_L(0); PG8_MMA(0, 0, At, B0); PG8_BAR; PG8_SCHED;
            PG8_LDB(B1, 0, 1); PG8_STAGE(PG8_SB(0, 0), b2, voffB);
            PG8_BAR; PG8_WAIT_L(0); PG8_MMA(0, 1, At, B1); PG8_BAR;
            PG8_LDA(At, 0, 1); PG8_STAGE(PG8_SA(0, 0), a2, voffA);
            PG8_BAR; PG8_WAIT_L(0); PG8_MMA(1, 0, At, B0); PG8_BAR; PG8_SCHED;
            PG8_STAGE(PG8_SB(0, 1), b2 + hstep, voffB);
            PG8_WAIT_V(6); PG8_BAR; PG8_MMA(1, 1, At, B1); PG8_BAR;
            PG8_LDB(B0, 1, 0); PG8_SCHED; PG8_LDA(At, 1, 0); PG8_STAGE(PG8_SA(0, 1), a2 + hstep, voffA);
            PG8_WAIT_L(8); PG8_BAR; PG8_WAIT_L(0); PG8_MMA(0, 0, At, B0); PG8_BAR; PG8_SCHED;
            PG8_LDB(B1, 1, 1); PG8_STAGE(PG8_SB(1, 0), b3, voffB);
            PG8_BAR; PG8_WAIT_L(0); PG8_MMA(0, 1, At, B1); PG8_BAR;
            PG8_LDA(At, 1, 1); PG8_STAGE(PG8_SA(1, 0), a3, voffA);
            PG8_BAR; PG8_WAIT_L(0); PG8_MMA(1, 0, At, B0); PG8_BAR; PG8_SCHED;
            PG8_STAGE(PG8_SB(1, 1), b3 + hstep, voffB);
            PG8_WAIT_V(6); PG8_BAR; PG8_MMA(1, 1, At, B1); PG8_BAR;
            }
        }
        if constexpr (ALIGN_EPI) { if (wr == 0) PG8_BAR; }
        if constexpr (!Epi::AFTER_DRAIN) { E(acc, cur, wr, wc, fr, fq); S.done(cur); }
        if (!has_next) break;
#pragma unroll
        for (int a = 0; a < 2; ++a)
#pragma unroll
            for (int b = 0; b < 2; ++b)
#pragma unroll
                for (int m = 0; m < 4; ++m)
#pragma unroll
                    for (int n = 0; n < 2; ++n) acc[a][b][m][n] = (f32x4){0.f, 0.f, 0.f, 0.f};
        cur = nxt; cA = nA; cB = nB; ++ui;
        if constexpr (ALIGN_EPI) { if (wr == 1) PG8_BAR; }
    }
    PG8_WAIT_V(0);
    if constexpr (!ALIGN_EPI) { if (wr == 0) PG8_BAR; }
    PG8_BAR;
    if constexpr (Epi::AFTER_DRAIN) { E.fused(acc, cur, wr, wc, fr, fq, lds, wid, lane); S.done(cur); }
#undef PG8_SA
#undef PG8_SB
#undef PG8_STAGE
#undef PG8_LDA
#undef PG8_LDB
#undef PG8_MMA
#undef PG8_WAIT_V
#undef PG8_WAIT_L
#undef PG8_BAR
#undef PG8_SCHED
}
}
constexpr int NB = 8, SEQ = 2048, DM = 1024, M = NB * SEQ, INW = 3328, MIXW = 2048, FF = 4096;
constexpr int OFF_G = 1024, OFF_Q = 2048, OFF_K = 3072, OFF_V = 3200;
constexpr float LOG2E = 1.4426950408889634f;
constexpr float QSCALE = 0.125f * LOG2E;
constexpr int NWAVES = 8;
constexpr size_t MiB = 1u << 20;
constexpr size_t WS_WIN = 1 * MiB, WS_WOUT = 8 * MiB, WS_WUP = 12 * MiB, WS_WDN = 20 * MiB, WS_WG = 28 * MiB;
constexpr size_t WS_SSQ_LRU = 29 * MiB  , WS_SSQ_ATT = 31 * MiB  ;
constexpr size_t WS_HN = 32 * MiB  , WS_PROJ = 64 * MiB  , WS_MIX = 168 * MiB  ;
constexpr size_t WS_H = 64 * MiB  ;
constexpr size_t WS_SSQ_X1 = 232 * MiB  , WS_SSQ_X2 = 233 * MiB, WS_END = 234 * MiB;
constexpr int RING_BYTES = 131072, TAB_OFF = RING_BYTES + 512, LDS_BYTES = 147456;

#define LAS __attribute__((address_space(3)))
typedef unsigned short bf16;
typedef unsigned v4u __attribute__((ext_vector_type(4)));
typedef unsigned v2u __attribute__((ext_vector_type(2)));
typedef float f32x4 __attribute__((ext_vector_type(4)));
typedef float f32x16 __attribute__((ext_vector_type(16)));
typedef short bf16x8 __attribute__((ext_vector_type(8)));
typedef short s16x4 __attribute__((ext_vector_type(4)));
__device__ __forceinline__ float bf2f(unsigned short h) { return __uint_as_float((unsigned)h << 16); }
__device__ __forceinline__ unsigned pk2(float lo, float hi) { return pg8::cvt_pk_bf16(lo, hi); }
__device__ __forceinline__ float wave_sum(float v) {
#pragma unroll
    for (int o = 1; o < 64; o <<= 1) v += __shfl_xor(v, o);
    return v;
}
__device__ __forceinline__ void p0_transpose_item(const float* W, int K, int N, bf16* WT, const float* gain, LAS float* scr, int item, int lane) {
    const int nblk = N / 32, kb = item / nblk, nb = item % nblk, k0 = 64 * kb, n0 = 32 * nb;
#pragma unroll 8
    for (int i = 0; i < 32; ++i) { const int kk = 2 * i + (lane >> 5); float v = W[(size_t)(k0 + kk) * N + n0 + (lane & 31)]; if (gain) v *= gain[k0 + kk]; scr[kk * 33 + (lane & 31)] = v; }
    asm volatile("s_waitcnt lgkmcnt(0)" ::: "memory");
    const int c = lane & 7;
#pragma unroll
    for (int j = 0; j < 4; ++j) { const int n = (lane >> 3) + 8 * j; const LAS float* s = scr + (8 * c) * 33 + n;
        v4u o; o.x = pk2(s[0 * 33], s[1 * 33]); o.y = pk2(s[2 * 33], s[3 * 33]); o.z = pk2(s[4 * 33], s[5 * 33]); o.w = pk2(s[6 * 33], s[7 * 33]);
        *(v4u*)(WT + (size_t)(n0 + n) * K + k0 + 8 * c) = o; }
    asm volatile("s_waitcnt lgkmcnt(0)" ::: "memory");
}
struct Args { const float* in[18]; float* out; unsigned char* ws; };

__device__ __forceinline__ void p0_prologue(const Args& A, LAS unsigned char* lds, int vcu, int G, int wave, int lane) {
    LAS float* scr = (LAS float*)(lds + wave * 16384);
    const int gw = vcu * NWAVES + wave, NGW = G * NWAVES;
    unsigned char* ws = A.ws;
    constexpr int I_IN = (DM / 64) * (INW / 32), I_OUT = (MIXW / 64) * (DM / 32), I_UP = (DM / 64) * (FF / 32), I_DN = (FF / 64) * (DM / 32), I_G = 2 * 16 * 2;
    constexpr int NITEMS = I_IN + I_OUT + I_UP + I_DN + I_G;
    for (int it = gw; it < NITEMS; it += NGW) {
        int r = it;
        if (r < I_IN) { p0_transpose_item(A.in[2], DM, INW, (bf16*)(ws + WS_WIN), nullptr, scr, r, lane); continue; } r -= I_IN;
        if (r < I_OUT) { const int kb = r / (DM / 32); const float* g = (kb < 16) ? A.in[11] : (A.in[12] - 1024);
            p0_transpose_item(A.in[13], MIXW, DM, (bf16*)(ws + WS_WOUT), g, scr, r, lane); continue; } r -= I_OUT;
        if (r < I_UP) { p0_transpose_item(A.in[15], DM, FF, (bf16*)(ws + WS_WUP), A.in[14], scr, r, lane); continue; } r -= I_UP;
        if (r < I_DN) { p0_transpose_item(A.in[16], FF, DM, (bf16*)(ws + WS_WDN), nullptr, scr, r, lane); continue; } r -= I_DN;
        { const int gate = r / 32, n = (r % 32) / 2, sub = r % 2;
          p0_transpose_item(A.in[gate ? 7 : 5] + n * 4096, 64, 64, (bf16*)(ws + WS_WG) + gate * 65536 + n * 4096, nullptr, scr, sub, lane); }
    }
    const f32x4* gp = (const f32x4*)A.in[1] + lane;
    for (int m = gw; m < M; m += NGW) {
        const f32x4* xr = (const f32x4*)(A.in[0] + (size_t)m * DM) + lane;
        f32x4 v[4]; float s = 0.f;
#pragma unroll
        for (int j = 0; j < 4; ++j) { v[j] = xr[64 * j]; s += (v[j].x * v[j].x + v[j].y * v[j].y) + (v[j].z * v[j].z + v[j].w * v[j].w); }
        const float rs = 1.0f / sqrtf(wave_sum(s) * (1.f / DM) + 1e-6f);
        unsigned long long* o8 = (unsigned long long*)((bf16*)(ws + WS_HN) + (size_t)m * DM) + lane;
#pragma unroll
        for (int j = 0; j < 4; ++j) { const f32x4 g = gp[64 * j]; o8[64 * j] = (unsigned long long)pk2(v[j].x * rs * g.x, v[j].y * rs * g.y) | ((unsigned long long)pk2(v[j].z * rs * g.z, v[j].w * rs * g.w) << 32); }
    }
}

__device__ __forceinline__ int crow(int r, int hi) { return (r & 3) + 8 * (r >> 2) + 4 * hi; }
__device__ __forceinline__ void attn_unit(LAS unsigned char* lds, int b, int j, int kvh, const bf16* proj, const float* sinks, bf16* mixed, float* ssq_attn) {
    const int tid = threadIdx.x, lane = tid & 63, wave = tid >> 6, r32 = lane & 31, hi = lane >> 5;
    constexpr int VROW = 264;
    LAS unsigned char* Kl = lds;
    LAS unsigned short* Vt = (LAS unsigned short*)(lds + 32768);
    const size_t rowb = (size_t)b * SEQ; const int tok0 = (j - 1) * 128;
    __syncthreads();
#pragma unroll
    for (int it = 0; it < 4; ++it) { const int idx = tid + it * 512, key = idx >> 3, c = idx & 7, tok = tok0 + key;
        v4u kv = (v4u){0u, 0u, 0u, 0u}, vv = (v4u){0u, 0u, 0u, 0u};
        if (tok >= 0) { const bf16* p = proj + (rowb + tok) * INW + OFF_K + kvh * 64 + c * 8; kv = *(const v4u*)p; vv = *(const v4u*)(p + 128); }
        *(LAS v4u*)(Kl + c * 4096 + key * 16) = kv;
        LAS unsigned short* vp = Vt + (c * 8) * VROW + key;
        vp[0 * VROW] = (unsigned short)(vv.x & 0xffffu); vp[1 * VROW] = (unsigned short)(vv.x >> 16);
        vp[2 * VROW] = (unsigned short)(vv.y & 0xffffu); vp[3 * VROW] = (unsigned short)(vv.y >> 16);
        vp[4 * VROW] = (unsigned short)(vv.z & 0xffffu); vp[5 * VROW] = (unsigned short)(vv.z >> 16);
        vp[6 * VROW] = (unsigned short)(vv.w & 0xffffu); vp[7 * VROW] = (unsigned short)(vv.w >> 16); }
    __syncthreads();
    const int head = kvh * 8 + wave;
    const float sink2 = sinks[head] * LOG2E;
#pragma unroll 1
    for (int s = 0; s < 4; ++s) {
        const size_t qrow = rowb + j * 128 + 32 * s + r32;
        bf16x8 qf[4];
#pragma unroll
        for (int ks = 0; ks < 4; ++ks) qf[ks] = *(const bf16x8*)(proj + qrow * INW + OFF_Q + head * 64 + 16 * ks + 8 * hi);
        f32x16 S[5];
#pragma unroll
        for (int t5 = 0; t5 < 5; ++t5) { const int kt = s + t5; f32x16 a = {};
#pragma unroll
            for (int ks = 0; ks < 4; ++ks) { const bf16x8 kf = *(const LAS bf16x8*)(Kl + (2 * ks + hi) * 4096 + (32 * kt + r32) * 16); a = __builtin_amdgcn_mfma_f32_32x32x16_bf16(kf, qf[ks], a, 0, 0, 0); }
            S[t5] = a; }
        const int qi = 32 * s + r32; const int jkmin = (j == 0) ? 128 : 0;
        float mx = -1e30f;
#pragma unroll
        for (int t5 = 0; t5 < 5; ++t5)
#pragma unroll
            for (int r = 0; r < 16; ++r) { const int jk = 32 * (s + t5) + crow(r, hi); const int dq = jk - qi; const bool ok = (dq >= 1) && (dq <= 128) && (jk >= jkmin);
                const float v = ok ? S[t5][r] : -1e30f; S[t5][r] = v; mx = fmaxf(mx, v); }
        mx = fmaxf(mx, __shfl_xor(mx, 32)); mx = fmaxf(mx, sink2);
        float l = 0.f;
#pragma unroll
        for (int t5 = 0; t5 < 5; ++t5)
#pragma unroll
            for (int r = 0; r < 16; ++r) { const float p = __builtin_amdgcn_exp2f(S[t5][r] - mx); S[t5][r] = p; l += p; }
        l += __shfl_xor(l, 32); l += __builtin_amdgcn_exp2f(sink2 - mx);
        f32x16 O[2]; O[0] = (f32x16){}; O[1] = (f32x16){};
#pragma unroll
        for (int t5 = 0; t5 < 5; ++t5)
#pragma unroll
            for (int k2 = 0; k2 < 2; ++k2) { const int kb = 32 * (s + t5) + 16 * k2 + 4 * hi;
                v4u pw; pw.x = pk2(S[t5][8 * k2 + 0], S[t5][8 * k2 + 1]); pw.y = pk2(S[t5][8 * k2 + 2], S[t5][8 * k2 + 3]); pw.z = pk2(S[t5][8 * k2 + 4], S[t5][8 * k2 + 5]); pw.w = pk2(S[t5][8 * k2 + 6], S[t5][8 * k2 + 7]);
                const bf16x8 pb = __builtin_bit_cast(bf16x8, pw);
#pragma unroll
                for (int dt = 0; dt < 2; ++dt) { const LAS unsigned short* vr = Vt + (32 * dt + r32) * VROW + kb;
                    const v2u lo = *(const LAS v2u*)vr, hh = *(const LAS v2u*)(vr + 8);
                    const v4u vw = (v4u){lo.x, lo.y, hh.x, hh.y};
                    O[dt] = __builtin_amdgcn_mfma_f32_32x32x16_bf16(__builtin_bit_cast(bf16x8, vw), pb, O[dt], 0, 0, 0); } }
        const float inv = 1.0f / l; float sq = 0.f;
        bf16* orow = mixed + qrow * MIXW + 1024 + head * 64;
#pragma unroll
        for (int dt = 0; dt < 2; ++dt)
#pragma unroll
            for (int g4 = 0; g4 < 4; ++g4) { const float o0 = O[dt][4 * g4] * inv, o1 = O[dt][4 * g4 + 1] * inv, o2 = O[dt][4 * g4 + 2] * inv, o3 = O[dt][4 * g4 + 3] * inv;
                sq += (o0 * o0 + o1 * o1) + (o2 * o2 + o3 * o3);
                v2u w; w.x = pk2(o0, o1); w.y = pk2(o2, o3); *(v2u*)(orow + 32 * dt + 8 * g4 + 4 * hi) = w; }
        sq += __shfl_xor(sq, 32);
        if (hi == 0) ssq_attn[qrow * 16 + head] = sq;
    }
}

__device__ __forceinline__ float sigm(float z) { return __builtin_amdgcn_rcpf(1.0f + __builtin_amdgcn_exp2f(-z * LOG2E)); }
__device__ __forceinline__ void lru_load_x(bf16x8 (&xr)[2][4], const bf16* xcol, size_t rowb, int t) {
#pragma unroll
    for (int tap = 0; tap < 4; ++tap) { const int tt = t - 3 + tap;
#pragma unroll
        for (int ks = 0; ks < 2; ++ks) { bf16x8 v = (bf16x8){0, 0, 0, 0, 0, 0, 0, 0}; if (tt >= 0) v = *(const bf16x8*)(xcol + (rowb + tt) * INW + 32 * ks); xr[ks][tap] = v; } }
}
__device__ __forceinline__ void lru_unit(LAS unsigned char* lds, int b, int n, int half, const bf16* proj, const bf16* WgA, const bf16* WgX, const float* conv_w, const float* conv_b,
                                         const float* b_a, const float* b_x, const float* lam, bf16* mixed, float* ssq_lru) {
    const int tid = threadIdx.x, lane = tid & 63, wave = tid >> 6, fr = lane & 15, fq = lane >> 4;
    LAS float* cwl = (LAS float*)lds;
    LAS float* exch = (LAS float*)(lds + 2048);
    LAS float* xcs = (LAS float*)(lds + 8192) + wave * (16 * 36);
    __syncthreads();
    if (tid < 320) { const int tap = tid >> 6, c = tid & 63; cwl[tid] = tap < 4 ? conv_w[tap * 1024 + n * 64 + c] : conv_b[n * 64 + c]; }
    __syncthreads();
    bf16x8 wa[2][2], wx[2][2]; float ba[2], bx[2], c1[2], hc[2];
#pragma unroll
    for (int nt = 0; nt < 2; ++nt) { const int dl = 32 * half + 16 * nt + fr, ch = n * 64 + dl;
#pragma unroll
        for (int ks = 0; ks < 2; ++ks) { const size_t idx = (size_t)(n * 64 + dl) * 64 + 32 * ks + 8 * fq; wa[nt][ks] = *(const bf16x8*)(WgA + idx); wx[nt][ks] = *(const bf16x8*)(WgX + idx); }
        ba[nt] = b_a[ch]; bx[nt] = b_x[ch]; const float L = lam[ch];
        const float sp = (L < -20.f) ? -L : log1pf(expf(-L));
        c1[nt] = -8.0f * sp * LOG2E; hc[nt] = 0.f; }
    const size_t rowb = (size_t)b * SEQ;
    const bf16* xcol = proj + n * 64 + 8 * fq;
    bf16x8 xcur[2][4];
    lru_load_x(xcur, xcol, rowb, wave * 16 + fr);
#pragma unroll 1
    for (int chunk = 0; chunk < 16; ++chunk) {
        const int tb = chunk * 128 + wave * 16;
        bf16x8 xnext[2][4];
        { const int cn = chunk < 15 ? chunk + 1 : 15; lru_load_x(xnext, xcol, rowb, cn * 128 + wave * 16 + fr); }
        unsigned short gv[2][4];
#pragma unroll
        for (int nt = 0; nt < 2; ++nt)
#pragma unroll
            for (int i = 0; i < 4; ++i) gv[nt][i] = proj[(rowb + tb + 4 * fq + i) * INW + OFF_G + n * 64 + 32 * half + 16 * nt + fr];
        float xc[2][8];
#pragma unroll
        for (int ks = 0; ks < 2; ++ks) {
            const f32x4 b0 = *(const LAS f32x4*)(cwl + 256 + 32 * ks + 8 * fq), b1 = *(const LAS f32x4*)(cwl + 256 + 32 * ks + 8 * fq + 4);
#pragma unroll
            for (int e = 0; e < 4; ++e) { xc[ks][e] = b0[e]; xc[ks][4 + e] = b1[e]; }
#pragma unroll
            for (int tap = 0; tap < 4; ++tap) { const f32x4 w0 = *(const LAS f32x4*)(cwl + tap * 64 + 32 * ks + 8 * fq), w1 = *(const LAS f32x4*)(cwl + tap * 64 + 32 * ks + 8 * fq + 4);
#pragma unroll
                for (int e = 0; e < 4; ++e) { xc[ks][e] += w0[e] * bf2f((unsigned short)xcur[ks][tap][e]); xc[ks][4 + e] += w1[e] * bf2f((unsigned short)xcur[ks][tap][4 + e]); } } }
        bf16x8 af[2];
#pragma unroll
        for (int ks = 0; ks < 2; ++ks) { v4u w; w.x = pk2(xc[ks][0], xc[ks][1]); w.y = pk2(xc[ks][2], xc[ks][3]); w.z = pk2(xc[ks][4], xc[ks][5]); w.w = pk2(xc[ks][6], xc[ks][7]); af[ks] = __builtin_bit_cast(bf16x8, w); }
        f32x4 ra[2], ia[2];
#pragma unroll
        for (int nt = 0; nt < 2; ++nt) { ra[nt] = (f32x4){0.f, 0.f, 0.f, 0.f}; ia[nt] = (f32x4){0.f, 0.f, 0.f, 0.f};
#pragma unroll
            for (int ks = 0; ks < 2; ++ks) { ra[nt] = __builtin_amdgcn_mfma_f32_16x16x32_bf16(af[ks], wa[nt][ks], ra[nt], 0, 0, 0); ia[nt] = __builtin_amdgcn_mfma_f32_16x16x32_bf16(af[ks], wx[nt][ks], ia[nt], 0, 0, 0); } }
        { const int ks = half; LAS float* wp = xcs + fr * 36 + 8 * fq;
          *(LAS f32x4*)wp = (f32x4){xc[ks][0], xc[ks][1], xc[ks][2], xc[ks][3]}; *(LAS f32x4*)(wp + 4) = (f32x4){xc[ks][4], xc[ks][5], xc[ks][6], xc[ks][7]}; }
        __builtin_amdgcn_wave_barrier(); asm volatile("s_waitcnt lgkmcnt(0)" ::: "memory");
        float Al[2][4], Hl[2][4], Ai[2], Hi[2];
#pragma unroll
        for (int nt = 0; nt < 2; ++nt) { float a_run = 1.f, h_run = 0.f;
#pragma unroll
            for (int i = 0; i < 4; ++i) { const float xv = xcs[(4 * fq + i) * 36 + 16 * nt + fr];
                const float r = sigm(ra[nt][i] + ba[nt]), ig = sigm(ia[nt][i] + bx[nt]);
                const float la2 = c1[nt] * r, a = __builtin_amdgcn_exp2f(la2);
                const float x2 = la2 * (2.0f * 0.6931471805599453f);
                const float em = (x2 > -0.03f) ? -x2 * (1.0f + x2 * (0.5f + x2 * (0.16666667f + x2 * 0.041666668f))) : 1.0f - a * a;
                const float bt = __builtin_amdgcn_sqrtf(em) * (ig * xv);
                h_run = a * h_run + bt; a_run *= a; Al[nt][i] = a_run; Hl[nt][i] = h_run; }
            float A = a_run, H = h_run;
            { const float Ap = __shfl_up(A, 16), Hp = __shfl_up(H, 16); if (fq >= 1) { H = A * Hp + H; A = A * Ap; } }
            { const float Ap = __shfl_up(A, 32), Hp = __shfl_up(H, 32); if (fq >= 2) { H = A * Hp + H; A = A * Ap; } }
            Ai[nt] = A; Hi[nt] = H; }
        __builtin_amdgcn_wave_barrier();
        const int buf = chunk & 1;
        if (fq == 3) {
#pragma unroll
            for (int nt = 0; nt < 2; ++nt) { LAS float* e = exch + ((buf * 8 + wave) * 32 + nt * 16 + fr) * 2; e[0] = Ai[nt]; e[1] = Hi[nt]; } }
        __syncthreads();
        float sq[4] = {0.f, 0.f, 0.f, 0.f}; float yv[2][4];
#pragma unroll
        for (int nt = 0; nt < 2; ++nt) {
            float hw = hc[nt], hin_w = 0.f;
#pragma unroll
            for (int w = 0; w < 8; ++w) { const LAS float* e = exch + ((buf * 8 + w) * 32 + nt * 16 + fr) * 2; const float Aw = e[0], Hw = e[1]; if (w == wave) hin_w = hw; hw = Aw * hw + Hw; }
            hc[nt] = hw;
            float Aex = __shfl_up(Ai[nt], 16), Hex = __shfl_up(Hi[nt], 16); if (fq == 0) { Aex = 1.f; Hex = 0.f; }
            const float hin = Aex * hin_w + Hex;
#pragma unroll
            for (int i = 0; i < 4; ++i) { const float h = Hl[nt][i] + Al[nt][i] * hin; const float g = bf2f(gv[nt][i]);
                const float u2 = 1.5957691216057308f * (g + 0.044715f * g * g * g);
                const float y = h * g * sigm(u2); yv[nt][i] = y; sq[i] += y * y; } }
#pragma unroll
        for (int i = 0; i < 4; ++i) { float s = sq[i]; s += __shfl_xor(s, 1); s += __shfl_xor(s, 2); s += __shfl_xor(s, 4); s += __shfl_xor(s, 8);
            const size_t row = rowb + tb + 4 * fq + i;
            if (fr == 0) ssq_lru[row * 32 + n * 2 + half] = s;
#pragma unroll
            for (int nt = 0; nt < 2; ++nt) { bf16 hb = (bf16)(pk2(yv[nt][i], 0.f) & 0xffffu); mixed[row * MIXW + n * 64 + 32 * half + 16 * nt + fr] = hb; } }
#pragma unroll
        for (int ks = 0; ks < 2; ++ks)
#pragma unroll
            for (int tap = 0; tap < 4; ++tap) xcur[ks][tap] = xnext[ks][tap];
    }
}

__global__ void __launch_bounds__(NWAVES * 64, 2) fwd_megakernel(Args args) {
    extern __shared__ __attribute__((aligned(16))) unsigned char lds_raw[];
    LAS unsigned char* lds = (LAS unsigned char*)lds_raw;
    cg::grid_group grid = cg::this_grid();
    const int tid = threadIdx.x, lane = tid & 63, wave = __builtin_amdgcn_readfirstlane(tid >> 6);
    const int G = gridDim.x, bx = blockIdx.x, vcu = (G % 8 == 0) ? (bx % 8) * (G / 8) + bx / 8 : bx;
    unsigned char* ws = args.ws;
    bf16* HN = (bf16*)(ws + WS_HN); bf16* PROJ = (bf16*)(ws + WS_PROJ); bf16* MIX = (bf16*)(ws + WS_MIX); bf16* HB = (bf16*)(ws + WS_H);
    float* SSQ_LRU = (float*)(ws + WS_SSQ_LRU); float* SSQ_ATT = (float*)(ws + WS_SSQ_ATT); float* SSQ_X1 = (float*)(ws + WS_SSQ_X1); float* SSQ_X2 = (float*)(ws + WS_SSQ_X2);

    p0_prologue(args, lds, vcu, G, wave, lane);
    grid.sync();

    { pg8::Gemm g{HN, (const bf16*)(ws + WS_WIN), M, INW, DM}; pg8::StaticOrder S; S.init(M, INW, G, bx);
      pg8::EpiProj E{PROJ, INW, QSCALE};
      pg8::gemm_phase<pg8::EpiProj, pg8::StaticOrder, true, true>(lds, g, S, E); }
    grid.sync();

    for (int u = vcu; u < 256; u += G) attn_unit(lds, u >> 5, (u >> 1) & 15, u & 1, PROJ, args.in[10], MIX, SSQ_ATT);
    for (int u = vcu; u < 256; u += G) lru_unit(lds, u >> 5, (u >> 1) & 15, u & 1, PROJ, (const bf16*)(ws + WS_WG), (const bf16*)(ws + WS_WG) + 65536, args.in[3], args.in[4], args.in[6], args.in[8], args.in[9], MIX, SSQ_LRU);
    grid.sync();

    { pg8::Gemm g{MIX, (const bf16*)(ws + WS_WOUT), M, DM, MIXW}; pg8::StaticOrder S; S.init(M, DM, G, bx);
      LAS float* ratio = (LAS float*)(lds + TAB_OFF); LAS float* rsl = ratio + 256;
      pg8::Unit u0; const bool has = S.next(0, u0);
      __syncthreads();
      if (has && tid < 256) { const size_t row = (size_t)u0.pm * 256 + tid; float sl = 0.f, sa = 0.f;
          const f32x4* pl = (const f32x4*)(SSQ_LRU + row * 32); const f32x4* pa = (const f32x4*)(SSQ_ATT + row * 16);
#pragma unroll
          for (int i = 0; i < 8; ++i) { const f32x4 v = pl[i]; sl += (v[0] + v[1]) + (v[2] + v[3]); }
#pragma unroll
          for (int i = 0; i < 4; ++i) { const f32x4 v = pa[i]; sa += (v[0] + v[1]) + (v[2] + v[3]); }
          const float rl = 1.0f / sqrtf(sl * (1.f / 1024.f) + 1e-6f), ra = 1.0f / sqrtf(sa * (1.f / 1024.f) + 1e-6f);
          ratio[tid] = rl / ra; rsl[tid] = ra; }
      __syncthreads();
      typedef pg8::EpiRes<true, true> EO;
      EO E{args.in[0], args.out, HN, SSQ_X1, ratio, rsl};
      pg8::gemm_phase<EO, pg8::StaticOrder, false, true>(lds, g, S, E); }
    grid.sync();

    { pg8::Gemm g{HN, (const bf16*)(ws + WS_WUP), M, FF, DM}; pg8::StaticOrder S; S.init(M, FF, G, bx);
      pg8::EpiUp E{HB, FF, SSQ_X1};
      pg8::gemm_phase<pg8::EpiUp, pg8::StaticOrder, true, true>(lds, g, S, E); }
    grid.sync();

    { pg8::Gemm g{HB, (const bf16*)(ws + WS_WDN), M, DM, FF}; pg8::StaticOrder S; S.init(M, DM, G, bx);
      typedef pg8::EpiRes<false, false> ED;
      ED E{args.out, args.out, nullptr, SSQ_X2, nullptr, nullptr};
      pg8::gemm_phase<ED, pg8::StaticOrder, false, true>(lds, g, S, E); }
    grid.sync();

    { const int gw = vcu * NWAVES + wave, NGW = G * NWAVES; const f32x4* gp = (const f32x4*)args.in[17] + lane;
      for (int m = gw; m < M; m += NGW) { const f32x4 p = *(const f32x4*)(SSQ_X2 + (size_t)m * 4);
          const float rs = 1.0f / sqrtf(((p[0] + p[1]) + (p[2] + p[3])) * (1.f / DM) + 1e-6f);
          f32x4* xr = (f32x4*)(args.out + (size_t)m * DM) + lane;
#pragma unroll
          for (int j = 0; j < 4; ++j) { const f32x4 v = xr[64 * j], g4 = gp[64 * j]; xr[64 * j] = v * rs * g4; } } }
}

extern "C" void kernel_launch(void* const* d_in, const int* in_sizes, int n_in, void* d_out, int out_size, void* d_ws, size_t ws_size, hipStream_t stream) {
    static int grid = 0;
    if (grid == 0) {
        int dev = 0, cus = 0, per_cu = 0;
        (void)hipGetDevice(&dev); (void)hipDeviceGetAttribute(&cus, hipDeviceAttributeMultiprocessorCount, dev);
        if (hipFuncSetAttribute((const void*)fwd_megakernel, hipFuncAttributeMaxDynamicSharedMemorySize, LDS_BYTES) != hipSuccess) fprintf(stderr, "kernel_launch: hipFuncSetAttribute failed\n");
        if (hipOccupancyMaxActiveBlocksPerMultiprocessor(&per_cu, (const void*)fwd_megakernel, NWAVES * 64, LDS_BYTES) != hipSuccess || per_cu < 1) per_cu = 1;
        (void)hipGetLastError();
        grid = cus * per_cu; if (grid > 256) grid = 256; if (grid < 1) grid = 256;
        if (n_in != 18 || ws_size < WS_END) fprintf(stderr, "kernel_launch: unexpected n_in %d / ws %zu\n", n_in, ws_size);
    }
    Args a{};
    for (int i = 0; i < 18; ++i) a.in[i] = (const float*)d_in[i];
    a.out = (float*)d_out; a.ws = (unsigned char*)d_ws;
    void* kargs[] = {&a};
    hipError_t e = hipLaunchCooperativeKernel((const void*)fwd_megakernel, dim3(grid), dim3(NWAVES * 64), kargs, LDS_BYTES, stream);
    if (e != hipSuccess) fprintf(stderr, "cooperative launch failed: %s (grid %d)\n", hipGetErrorString(e), grid);
}
```

```cpp
#include <hip/hip_runtime.h>
#include <hip/hip_cooperative_groups.h>
#include <cstdio>
#include <cstdint>
namespace cg = cooperative_groups;
namespace pg8 {
#define PG8_LAS __attribute__((address_space(3)))
typedef unsigned short bf16_t;
typedef short bf16x8 __attribute__((ext_vector_type(8)));
typedef float f32x4 __attribute__((ext_vector_type(4)));
typedef unsigned u32x4 __attribute__((ext_vector_type(4)));
constexpr int BM = 256, BK = 64, HALF = 128, HTB = HALF * BK * 2  , STAGE_BYTES = 8 * HTB, NXCD = 8, WGM = 8;

__host__ __device__ __forceinline__ int lds_byte(int r, int c) { const int st = (r >> 4) * 2 + (c >> 5), rr = r & 15, cc = c & 31, ob = rr * 64 + cc * 2; return st * 1024 + (ob ^ (((ob >> 9) & 1) << 5)); }
__host__ __device__ __forceinline__ void stage_rc(int b, int& R, int& C) { const int st = b / 1024, sb = b % 1024, swz = sb ^ (((sb >> 9) & 1) << 5); R = (st >> 1) * 16 + swz / 64; C = (st & 1) * 32 + (swz % 64) / 2; }
__host__ __device__ __forceinline__ int perm32(int rho) { const int n = rho >> 4, i = rho & 15; return 8 * (i >> 2) + 4 * n + (i & 3); }

struct Unit { int pm, pn; };
struct Gemm { const bf16_t* A; const bf16_t* Bt; int M, N, K; };

struct StaticOrder {
    int nM, nN, nwg, G, c;
    __host__ __device__ void init(int M, int N, int G_, int c_) { nM = M / BM; nN = N / BM; nwg = nM * nN; G = G_; c = c_; }
    __host__ __device__ bool next(int i, Unit& u) const {
        const long L = (long)i * G + c; if (L >= nwg) return false;
        int wgid = (int)L; { const int q = nwg / NXCD, r = nwg % NXCD, xcd = wgid % NXCD, off = wgid / NXCD; wgid = (xcd < r ? xcd * (q + 1) : r * (q + 1) + (xcd - r) * q) + off; }
        const int nig = WGM * nN, gid = wgid / nig, fm = gid * WGM, gsz = (nM - fm) < WGM ? (nM - fm) : WGM;
        u.pm = fm + ((wgid % nig) % gsz); u.pn = (wgid % nig) / gsz; return true;
    }
    __device__ __forceinline__ void a_ready(const Unit&) const {}
    __device__ __forceinline__ void done(const Unit&) const {}
};

__device__ __forceinline__ unsigned cvt_pk_bf16(float lo, float hi) { unsigned r; asm volatile("v_cvt_pk_bf16_f32 %0, %1, %2" : "=v"(r) : "v"(lo), "v"(hi)); return r; }
typedef float f32x2 __attribute__((ext_vector_type(2)));
constexpr float RMS_EPS = 1e-6f;
__device__ __forceinline__ u32x4 pack8(f32x4 v0, f32x4 v1) { u32x4 w; w.x = cvt_pk_bf16(v0[0], v0[1]); w.y = cvt_pk_bf16(v0[2], v0[3]); w.z = cvt_pk_bf16(v1[0], v1[1]); w.w = cvt_pk_bf16(v1[2], v1[3]); return w; }

struct EpiProj {
    static constexpr bool PERM = true, AFTER_DRAIN = false, MIDK = false;
    bf16_t* O; int ldc; float qscale;
    __device__ __forceinline__ void midk(f32x4 (&)[2][2][4][2], int, int) const {}
    __device__ __forceinline__ void operator()(const f32x4 (&acc)[2][2][4][2], const Unit& u, int wr, int wc, int fr, int fq) const {
        const int row0 = u.pm * BM + wr * 64 + fr, col0 = u.pn * BM + wc * 32 + 8 * fq;
        const float sc = (u.pn >= 8 && u.pn < 12) ? qscale : 1.f;
#pragma unroll
        for (int ai = 0; ai < 2; ++ai)
#pragma unroll
            for (int m = 0; m < 4; ++m) { bf16_t* rowp = O + (size_t)(row0 + ai * HALF + m * 16) * ldc + col0;
#pragma unroll
                for (int bj = 0; bj < 2; ++bj) *(u32x4*)(rowp + bj * HALF) = pack8(acc[ai][bj][m][0] * sc, acc[ai][bj][m][1] * sc); }
    }
};
struct EpiUp {
    static constexpr bool PERM = true, AFTER_DRAIN = false, MIDK = false;
    bf16_t* O; int ldc; const float* ssq;
    __device__ __forceinline__ void midk(f32x4 (&)[2][2][4][2], int, int) const {}
    __device__ __forceinline__ void operator()(const f32x4 (&acc)[2][2][4][2], const Unit& u, int wr, int wc, int fr, int fq) const {
        const int row0 = u.pm * BM + wr * 64 + fr, col0 = u.pn * BM + wc * 32 + 8 * fq;
#pragma unroll
        for (int ai = 0; ai < 2; ++ai)
#pragma unroll
            for (int m = 0; m < 4; ++m) { const int row = row0 + ai * HALF + m * 16; const f32x4 p = *(const f32x4*)(ssq + (size_t)row * 4);
                const float rs = __builtin_amdgcn_rsqf(((p[0] + p[1]) + (p[2] + p[3])) * (1.0f / 1024.0f) + RMS_EPS);
                bf16_t* rowp = O + (size_t)row * ldc + col0;
#pragma unroll
                for (int bj = 0; bj < 2; ++bj) { f32x4 v0 = acc[ai][bj][m][0] * rs, v1 = acc[ai][bj][m][1] * rs;
#pragma unroll
                    for (int e = 0; e < 4; ++e) { const float a = fmaxf(v0[e], 0.f), b = fmaxf(v1[e], 0.f); v0[e] = a * a; v1[e] = b * b; }
                    *(u32x4*)(rowp + bj * HALF) = pack8(v0, v1); } }
    }
};
template <bool HAS_MIDK, bool HAS_B16> struct EpiRes {
    static constexpr bool PERM = true, AFTER_DRAIN = true, MIDK = HAS_MIDK;
    const float* base; float* out; bf16_t* ob; float* ssq; const PG8_LAS float* ratio; const PG8_LAS float* rsl;
    __device__ __forceinline__ void midk(f32x4 (&acc)[2][2][4][2], int wr, int fr) const {
#pragma unroll
        for (int ai = 0; ai < 2; ++ai)
#pragma unroll
            for (int m = 0; m < 4; ++m) { const float f = ratio[ai * HALF + wr * 64 + m * 16 + fr];
#pragma unroll
                for (int bj = 0; bj < 2; ++bj) { acc[ai][bj][m][0] = acc[ai][bj][m][0] * f; acc[ai][bj][m][1] = acc[ai][bj][m][1] * f; } }
    }
    __device__ __forceinline__ void fused(f32x4 (&acc)[2][2][4][2], const Unit& u, int wr, int wc, int fr, int fq, PG8_LAS unsigned char* lds, int wid, int lane) const {
        PG8_LAS float* P = (PG8_LAS float*)lds;
#pragma unroll
        for (int ai = 0; ai < 2; ++ai)
#pragma unroll
            for (int m = 0; m < 4; ++m) { const int r = ai * HALF + wr * 64 + m * 16 + fr; const size_t row = (size_t)u.pm * BM + r;
                const float rs = HAS_MIDK ? rsl[r] : 1.f; float s = 0.f;
#pragma unroll
                for (int bj = 0; bj < 2; ++bj) { const size_t off = row * 1024 + u.pn * BM + bj * HALF + wc * 32 + 8 * fq;
                    const f32x4 xa = *(const f32x4*)(base + off), xb = *(const f32x4*)(base + off + 4);
                    const f32x4 v0 = xa + acc[ai][bj][m][0] * rs, v1 = xb + acc[ai][bj][m][1] * rs;
                    *(f32x4*)(out + off) = v0; *(f32x4*)(out + off + 4) = v1;
                    if (HAS_B16) *(u32x4*)(ob + off) = pack8(v0, v1);
                    s += (v0[0] * v0[0] + v0[1] * v0[1]) + (v0[2] * v0[2] + v0[3] * v0[3]) + (v1[0] * v1[0] + v1[1] * v1[1]) + (v1[2] * v1[2] + v1[3] * v1[3]); }
                s += __shfl_xor(s, 16); s += __shfl_xor(s, 32);
                if (fq == 0) P[r * 4 + wc] = s; }
        __syncthreads();
        const int t = wid * 64 + lane;
        if (t < 256) { const float s = (P[t * 4] + P[t * 4 + 1]) + (P[t * 4 + 2] + P[t * 4 + 3]); ssq[((size_t)u.pm * BM + t) * 4 + u.pn] = s; }
    }
};

template <class Epi, class Sched, bool ALIGN_EPI = false, bool SP2 = false>
__device__ __forceinline__ void gemm_phase(PG8_LAS unsigned char* lds, const Gemm g, const Sched& S, const Epi& E) {
    const int tid = threadIdx.x, wid = __builtin_amdgcn_readfirstlane(tid >> 6), lane = tid & 63, wr = wid >> 2, wc = wid & 3, fr = lane & 15, fq = lane >> 4;
    const int K = g.K, nt = K / BK;
    unsigned voffA[2], voffB[2];
#pragma unroll
    for (int i = 0; i < 2; ++i) { int R, C; stage_rc(tid * 16 + i * 8192, R, C); const int Rb = Epi::PERM ? ((R & ~31) + perm32(R & 31)) : R;
        voffA[i] = (unsigned)(R * K + C) * 2u; voffB[i] = (unsigned)(Rb * K + C) * 2u; }
    const size_t kstep = (size_t)(BK * 2);
    const size_t hstep = (size_t)HALF * K * 2;
    const size_t tstep = 2 * hstep;
    const unsigned ldsw = (unsigned)wid * 1024u;
    const int aoff = lds_byte(wr * 64 + fr, fq * 8), boff = lds_byte(wc * 32 + fr, fq * 8);
#define PG8_SA(b, h) (((b) * 2 + (h)) * HTB)
#define PG8_SB(b, h) ((4 + (b) * 2 + (h)) * HTB)
#define PG8_STAGE(bufoff, gbase, voff) do { _Pragma("unroll") for (int _i = 0; _i < 2; ++_i) \
        __builtin_amdgcn_global_load_lds((const unsigned*)((const char*)(gbase) + (voff)[_i]), (PG8_LAS unsigned*)(lds + (bufoff) + ldsw + _i * 8192), 16, 0, 0); } while (0)
#define PG8_LDA(dst, b, h) do { _Pragma("unroll") for (int m = 0; m < 4; ++m) _Pragma("unroll") for (int k = 0; k < 2; ++k) dst[m][k] = *(const PG8_LAS bf16x8*)(lds + PG8_SA(b, h) + aoff + m * 2048 + k * 1024); } while (0)
#define PG8_LDB(dst, b, h) do { _Pragma("unroll") for (int n = 0; n < 2; ++n) _Pragma("unroll") for (int k = 0; k < 2; ++k) dst[n][k] = *(const PG8_LAS bf16x8*)(lds + PG8_SB(b, h) + boff + n * 2048 + k * 1024); } while (0)
#define PG8_MMA(ai, bj, At, Bt) do { __builtin_amdgcn_s_setprio(1); _Pragma("unroll") for (int m = 0; m < 4; ++m) _Pragma("unroll") for (int n = 0; n < 2; ++n) _Pragma("unroll") for (int k = 0; k < 2; ++k) \
        acc[ai][bj][m][n] = __builtin_amdgcn_mfma_f32_16x16x32_bf16(Bt[n][k], At[m][k], acc[ai][bj][m][n], 0, 0, 0); __builtin_amdgcn_s_setprio(0); } while (0)
#define PG8_WAIT_V(n) asm volatile("s_waitcnt vmcnt(" #n ")" ::: "memory")
#define PG8_WAIT_L(n) asm volatile("s_waitcnt lgkmcnt(" #n ")" ::: "memory")
#define PG8_BAR __builtin_amdgcn_s_barrier()
#define PG8_SCHED __builtin_amdgcn_sched_barrier(0)
    Unit cur, nxt; int ui = 0;
    if (!S.next(0, cur)) return;
    f32x4 acc[2][2][4][2];
#pragma unroll
    for (int a = 0; a < 2; ++a)
#pragma unroll
        for (int b = 0; b < 2; ++b)
#pragma unroll
            for (int m = 0; m < 4; ++m)
#pragma unroll
                for (int n = 0; n < 2; ++n) acc[a][b][m][n] = (f32x4){0.f, 0.f, 0.f, 0.f};
    bf16x8 At[4][2], B0[2][2], B1[2][2];
    const char* cA = (const char*)g.A + (size_t)cur.pm * tstep; const char* cB = (const char*)g.Bt + (size_t)cur.pn * tstep;
    S.a_ready(cur);
    if constexpr (SP2) {
        PG8_STAGE(PG8_SB(0, 0), cB, voffB); PG8_STAGE(PG8_SB(0, 1), cB + hstep, voffB); PG8_STAGE(PG8_SA(0, 0), cA, voffA); PG8_STAGE(PG8_SA(0, 1), cA + hstep, voffA);
        if (wr == 1) PG8_BAR;
        PG8_WAIT_V(2); PG8_BAR;
        PG8_STAGE(PG8_SB(1, 0), cB + kstep, voffB); PG8_STAGE(PG8_SA(1, 0), cA + kstep, voffA); PG8_STAGE(PG8_SB(1, 1), cB + hstep + kstep, voffB);
        PG8_WAIT_V(6); PG8_BAR;
    } else {
        PG8_STAGE(PG8_SB(0, 0), cB, voffB); PG8_STAGE(PG8_SA(0, 0), cA, voffA); PG8_STAGE(PG8_SB(0, 1), cB + hstep, voffB); PG8_STAGE(PG8_SA(0, 1), cA + hstep, voffA);
        if (wr == 1) PG8_BAR;
        PG8_WAIT_V(4); PG8_BAR;
        PG8_STAGE(PG8_SB(1, 0), cB + kstep, voffB); PG8_STAGE(PG8_SA(1, 0), cA + kstep, voffA); PG8_STAGE(PG8_SB(1, 1), cB + hstep + kstep, voffB);
        PG8_WAIT_V(6); PG8_BAR;
    }
    for (;;) {
        const bool has_next = S.next(ui + 1, nxt);
        const char* nA = has_next ? (const char*)g.A + (size_t)nxt.pm * tstep : cA; const char* nB = has_next ? (const char*)g.Bt + (size_t)nxt.pn * tstep : cB;
        for (int t = 0; t < nt; t += 2) {
            const bool last = (t == nt - 2);
            const char* a1 = cA + (size_t)(t + 1) * kstep;
            const char* a2 = last ? nA : cA + (size_t)(t + 2) * kstep; const char* b2 = last ? nB : cB + (size_t)(t + 2) * kstep;
            const char* a3 = a2 + kstep; const char* b3 = b2 + kstep;
            if (last && has_next) S.a_ready(nxt);
            if constexpr (Epi::MIDK) { if (t == nt / 2) E.midk(acc, wr, fr); }
            if constexpr (SP2) {
            PG8_LDB(B0, 0, 0); PG8_LDB(B1, 0, 1); PG8_SCHED; PG8_LDA(At, 0, 0); PG8_STAGE(PG8_SA(1, 1), a1 + hstep, voffA);
            PG8_WAIT_V(8); PG8_WAIT_L(0); PG8_BAR; PG8_MMA(0, 0, At, B0); PG8_MMA(0, 1, At, B1); PG8_BAR; PG8_SCHED;
            PG8_LDA(At, 0, 1); PG8_STAGE(PG8_SB(0, 0), b2, voffB); PG8_STAGE(PG8_SB(0, 1), b2 + hstep, voffB); PG8_STAGE(PG8_SA(0, 0), a2, voffA);
            PG8_WAIT_V(8); PG8_WAIT_L(0); PG8_BAR; PG8_MMA(1, 0, At, B0); PG8_MMA(1, 1, At, B1); PG8_BAR; PG8_SCHED;
            PG8_LDB(B0, 1, 0); PG8_LDB(B1, 1, 1); PG8_SCHED; PG8_LDA(At, 1, 0); PG8_STAGE(PG8_SA(0, 1), a2 + hstep, voffA);
            PG8_WAIT_V(8); PG8_WAIT_L(0); PG8_BAR; PG8_MMA(0, 0, At, B0); PG8_MMA(0, 1, At, B1); PG8_BAR; PG8_SCHED;
            PG8_LDA(At, 1, 1); PG8_STAGE(PG8_SB(1, 0), b3, voffB); PG8_STAGE(PG8_SB(1, 1), b3 + hstep, voffB); PG8_STAGE(PG8_SA(1, 0), a3, voffA);
            PG8_WAIT_V(8); PG8_WAIT_L(0); PG8_BAR; PG8_MMA(1, 0, At, B0); PG8_MMA(1, 1, At, B1); PG8_BAR; PG8_SCHED;
            } else {
            PG8_LDB(B0, 0, 0); PG8_SCHED; PG8_LDA(At, 0, 0); PG8_STAGE(PG8_SA(1, 1), a1 + hstep, voffA);
            PG8_WAIT_L(8); PG8_BAR; PG8_WAIT_L(0); PG8_MMA(0, 0, At, B0); PG8_BAR; PG8_SCHED;
            PG8_LDB(B1, 0, 1); PG8_STAGE(PG8_SB(0, 0), b2, voffB);
            PG8_BAR; PG8_WAIT_L(0); PG8_MMA(0, 1, At, B1); PG8_BAR;
            PG8_LDA(At, 0, 1); PG8_STAGE(PG8_SA(0, 0), a2, voffA);
            PG8_BAR; PG8_WAIT_L(0); PG8_MMA(1, 0, At, B0); PG8_BAR; PG8_SCHED;
            PG8_STAGE(PG8_SB(0, 1), b2 + hstep, voffB);
            PG8_WAIT_V(6); PG8_BAR; PG8_MMA(1, 1, At, B1); PG8_BAR;
            PG8_LDB(B0, 1, 0); PG8_SCHED; PG8_LDA(At, 1, 0); PG8_STAGE(PG8_SA(0, 1), a2 + hstep, voffA);
            PG8_WAIT_L(8); PG8_BAR; PG8_WAIT_L(0); PG8_MMA(0, 0, At, B0); PG8_BAR; PG8_SCHED;
            PG8_LDB(B1, 1, 1); PG8_STAGE(PG8_SB(1, 0), b3, voffB);
            PG8_BAR; PG8_WAIT_L(0); PG8_MMA(0, 1, At, B1); PG8_BAR;
            PG8_LDA(At, 1, 1); PG8_STAGE(PG8_SA(1, 0), a3, voffA);
            PG8_BAR; PG8_WAIT_L(0); PG8_MMA(1, 0, At, B0); PG8_BAR; PG8_SCHED;
            PG8_STAGE(PG8_SB(1, 1), b3 + hstep, voffB);
            PG8_WAIT_V(6); PG8_BAR; PG8_MMA(1, 1, At, B1); PG8_BAR;
            }
        }
        if constexpr (ALIGN_EPI) { if (wr == 0) PG8_BAR; }
        if constexpr (!Epi::AFTER_DRAIN) { E(acc, cur, wr, wc, fr, fq); S.done(cur); }
        if (!has_next) break;
#pragma unroll
        for (int a = 0; a < 2; ++a)
#pragma unroll
            for (int b = 0; b < 2; ++b)
#pragma unroll
                for (int m = 0; m < 4; ++m)
#pragma unroll
                    for (int n = 0; n < 2; ++n) acc[a][b][m][n] = (f32x4){0.f, 0.f, 0.f, 0.f};
        cur = nxt; cA = nA; cB = nB; ++ui;
        if constexpr (ALIGN_EPI) { if (wr == 1) PG8_BAR; }
    }
    PG8_WAIT_V(0);
    if constexpr (!ALIGN_EPI) { if (wr == 0) PG8_BAR; }
    PG8_BAR;
    if constexpr (Epi::AFTER_DRAIN) { E.fused(acc, cur, wr, wc, fr, fq, lds, wid, lane); S.done(cur); }
#undef PG8_SA
#undef PG8_SB
#undef PG8_STAGE
#undef PG8_LDA
#undef PG8_LDB
#undef PG8_MMA
#undef PG8_WAIT_V
#undef PG8_WAIT_L
#undef PG8_BAR
#undef PG8_SCHED
}
}
constexpr int NB = 8, SEQ = 2048, DM = 1024, M = NB * SEQ, INW = 3328, MIXW = 2048, FF = 4096;
constexpr int OFF_G = 1024, OFF_Q = 2048, OFF_K = 3072, OFF_V = 3200;
constexpr float LOG2E = 1.4426950408889634f;
constexpr float QSCALE = 0.125f * LOG2E;
constexpr int NWAVES = 8;
constexpr size_t MiB = 1u << 20;
constexpr size_t WS_WIN = 1 * MiB, WS_WOUT = 8 * MiB, WS_WUP = 12 * MiB, WS_WDN = 20 * MiB, WS_WG = 28 * MiB;
constexpr size_t WS_SSQ_LRU = 29 * MiB  , WS_SSQ_ATT = 31 * MiB  ;
constexpr size_t WS_HN = 32 * MiB  , WS_PROJ = 64 * MiB  , WS_MIX = 168 * MiB  ;
constexpr size_t WS_H = 64 * MiB  ;
constexpr size_t WS_SSQ_X1 = 232 * MiB  , WS_SSQ_X2 = 233 * MiB, WS_END = 234 * MiB;
constexpr int RING_BYTES = 131072, TAB_OFF = RING_BYTES + 512, LDS_BYTES = 147456;

#define LAS __attribute__((address_space(3)))
typedef unsigned short bf16;
typedef unsigned v4u __attribute__((ext_vector_type(4)));
typedef unsigned v2u __attribute__((ext_vector_type(2)));
typedef float f32x4 __attribute__((ext_vector_type(4)));
typedef float f32x16 __attribute__((ext_vector_type(16)));
typedef short bf16x8 __attribute__((ext_vector_type(8)));
typedef short s16x4 __attribute__((ext_vector_type(4)));
__device__ __forceinline__ float bf2f(unsigned short h) { return __uint_as_float((unsigned)h << 16); }
__device__ __forceinline__ unsigned pk2(float lo, float hi) { return pg8::cvt_pk_bf16(lo, hi); }
__device__ __forceinline__ float wave_sum(float v) {
#pragma unroll
    for (int o = 1; o < 64; o <<= 1) v += __shfl_xor(v, o);
    return v;
}
__device__ __forceinline__ void p0_transpose_item(const float* W, int K, int N, bf16* WT, const float* gain, LAS float* scr, int item, int lane) {
    const int nblk = N / 32, kb = item / nblk, nb = item % nblk, k0 = 64 * kb, n0 = 32 * nb;
#pragma unroll 8
    for (int i = 0; i < 32; ++i) { const int kk = 2 * i + (lane >> 5); float v = W[(size_t)(k0 + kk) * N + n0 + (lane & 31)]; if (gain) v *= gain[k0 + kk]; scr[kk * 33 + (lane & 31)] = v; }
    asm volatile("s_waitcnt lgkmcnt(0)" ::: "memory");
    const int c = lane & 7;
#pragma unroll
    for (int j = 0; j < 4; ++j) { const int n = (lane >> 3) + 8 * j; const LAS float* s = scr + (8 * c) * 33 + n;
        v4u o; o.x = pk2(s[0 * 33], s[1 * 33]); o.y = pk2(s[2 * 33], s[3 * 33]); o.z = pk2(s[4 * 33], s[5 * 33]); o.w = pk2(s[6 * 33], s[7 * 33]);
        *(v4u*)(WT + (size_t)(n0 + n) * K + k0 + 8 * c) = o; }
    asm volatile("s_waitcnt lgkmcnt(0)" ::: "memory");
}
struct Args { const float* in[18]; float* out; unsigned char* ws; };

__device__ __forceinline__ void p0_prologue(const Args& A, LAS unsigned char* lds, int vcu, int G, int wave, int lane) {
    LAS float* scr = (LAS float*)(lds + wave * 16384);
    const int gw = vcu * NWAVES + wave, NGW = G * NWAVES;
    unsigned char* ws = A.ws;
    constexpr int I_IN = (DM / 64) * (INW / 32), I_OUT = (MIXW / 64) * (DM / 32), I_UP = (DM / 64) * (FF / 32), I_DN = (FF / 64) * (DM / 32), I_G = 2 * 16 * 2;
    constexpr int NITEMS = I_IN + I_OUT + I_UP + I_DN + I_G;
    for (int it = gw; it < NITEMS; it += NGW) {
        int r = it;
        if (r < I_IN) { p0_transpose_item(A.in[2], DM, INW, (bf16*)(ws + WS_WIN), nullptr, scr, r, lane); continue; } r -= I_IN;
        if (r < I_OUT) { const int kb = r / (DM / 32); const float* g = (kb < 16) ? A.in[11] : (A.in[12] - 1024);
            p0_transpose_item(A.in[13], MIXW, DM, (bf16*)(ws + WS_WOUT), g, scr, r, lane); continue; } r -= I_OUT;
        if (r < I_UP) { p0_transpose_item(A.in[15], DM, FF, (bf16*)(ws + WS_WUP), A.in[14], scr, r, lane); continue; } r -= I_UP;
        if (r < I_DN) { p0_transpose_item(A.in[16], FF, DM, (bf16*)(ws + WS_WDN), nullptr, scr, r, lane); continue; } r -= I_DN;
        { const int gate = r / 32, n = (r % 32) / 2, sub = r % 2;
          p0_transpose_item(A.in[gate ? 7 : 5] + n * 4096, 64, 64, (bf16*)(ws + WS_WG) + gate * 65536 + n * 4096, nullptr, scr, sub, lane); }
    }
    const f32x4* gp = (const f32x4*)A.in[1] + lane;
    for (int m = gw; m < M; m += NGW) {
        const f32x4* xr = (const f32x4*)(A.in[0] + (size_t)m * DM) + lane;
        f32x4 v[4]; float s = 0.f;
#pragma unroll
        for (int j = 0; j < 4; ++j) { v[j] = xr[64 * j]; s += (v[j].x * v[j].x + v[j].y * v[j].y) + (v[j].z * v[j].z + v[j].w * v[j].w); }
        const float rs = 1.0f / sqrtf(wave_sum(s) * (1.f / DM) + 1e-6f);
        unsigned long long* o8 = (unsigned long long*)((bf16*)(ws + WS_HN) + (size_t)m * DM) + lane;
#pragma unroll
        for (int j = 0; j < 4; ++j) { const f32x4 g = gp[64 * j]; o8[64 * j] = (unsigned long long)pk2(v[j].x * rs * g.x, v[j].y * rs * g.y) | ((unsigned long long)pk2(v[j].z * rs * g.z, v[j].w * rs * g.w) << 32); }
    }
}

__device__ __forceinline__ int crow(int r, int hi) { return (r & 3) + 8 * (r >> 2) + 4 * hi; }
__device__ __forceinline__ void attn_unit(LAS unsigned char* lds, int b, int j, int kvh, const bf16* proj, const float* sinks, bf16* mixed, float* ssq_attn) {
    const int tid = threadIdx.x, lane = tid & 63, wave = tid >> 6, r32 = lane & 31, hi = lane >> 5;
    constexpr int VROW = 264;
    LAS unsigned char* Kl = lds;
    LAS unsigned short* Vt = (LAS unsigned short*)(lds + 32768);
    const size_t rowb = (size_t)b * SEQ; const int tok0 = (j - 1) * 128;
    __syncthreads();
#pragma unroll
    for (int it = 0; it < 4; ++it) { const int idx = tid + it * 512, key = idx >> 3, c = idx & 7, tok = tok0 + key;
        v4u kv = (v4u){0u, 0u, 0u, 0u}, vv = (v4u){0u, 0u, 0u, 0u};
        if (tok >= 0) { const bf16* p = proj + (rowb + tok) * INW + OFF_K + kvh * 64 + c * 8; kv = *(const v4u*)p; vv = *(const v4u*)(p + 128); }
        *(LAS v4u*)(Kl + c * 4096 + key * 16) = kv;
        LAS unsigned short* vp = Vt + (c * 8) * VROW + key;
        vp[0 * VROW] = (unsigned short)(vv.x & 0xffffu); vp[1 * VROW] = (unsigned short)(vv.x >> 16);
        vp[2 * VROW] = (unsigned short)(vv.y & 0xffffu); vp[3 * VROW] = (unsigned short)(vv.y >> 16);
        vp[4 * VROW] = (unsigned short)(vv.z & 0xffffu); vp[5 * VROW] = (unsigned short)(vv.z >> 16);
        vp[6 * VROW] = (unsigned short)(vv.w & 0xffffu); vp[7 * VROW] = (unsigned short)(vv.w >> 16); }
    __syncthreads();
    const int head = kvh * 8 + wave;
    const float sink2 = sinks[head] * LOG2E;
#pragma unroll 1
    for (int s = 0; s < 4; ++s) {
        const size_t qrow = rowb + j * 128 + 32 * s + r32;
        bf16x8 qf[4];
#pragma unroll
        for (int ks = 0; ks < 4; ++ks) qf[ks] = *(const bf16x8*)(proj + qrow * INW + OFF_Q + head * 64 + 16 * ks + 8 * hi);
        f32x16 S[5];
#pragma unroll
        for (int t5 = 0; t5 < 5; ++t5) { const int kt = s + t5; f32x16 a = {};
#pragma unroll
            for (int ks = 0; ks < 4; ++ks) { const bf16x8 kf = *(const LAS bf16x8*)(Kl + (2 * ks + hi) * 4096 + (32 * kt + r32) * 16); a = __builtin_amdgcn_mfma_f32_32x32x16_bf16(kf, qf[ks], a, 0, 0, 0); }
            S[t5] = a; }
        const int qi = 32 * s + r32; const int jkmin = (j == 0) ? 128 : 0;
        float mx = -1e30f;
#pragma unroll
        for (int t5 = 0; t5 < 5; ++t5)
#pragma unroll
            for (int r = 0; r < 16; ++r) { const int jk = 32 * (s + t5) + crow(r, hi); const int dq = jk - qi; const bool ok = (dq >= 1) && (dq <= 128) && (jk >= jkmin);
                const float v = ok ? S[t5][r] : -1e30f; S[t5][r] = v; mx = fmaxf(mx, v); }
        mx = fmaxf(mx, __shfl_xor(mx, 32)); mx = fmaxf(mx, sink2);
        float l = 0.f;
#pragma unroll
        for (int t5 = 0; t5 < 5; ++t5)
#pragma unroll
            for (int r = 0; r < 16; ++r) { const float p = __builtin_amdgcn_exp2f(S[t5][r] - mx); S[t5][r] = p; l += p; }
        l += __shfl_xor(l, 32); l += __builtin_amdgcn_exp2f(sink2 - mx);
        f32x16 O[2]; O[0] = (f32x16){}; O[1] = (f32x16){};
#pragma unroll
        for (int t5 = 0; t5 < 5; ++t5)
#pragma unroll
            for (int k2 = 0; k2 < 2; ++k2) { const int kb = 32 * (s + t5) + 16 * k2 + 4 * hi;
                v4u pw; pw.x = pk2(S[t5][8 * k2 + 0], S[t5][8 * k2 + 1]); pw.y = pk2(S[t5][8 * k2 + 2], S[t5][8 * k2 + 3]); pw.z = pk2(S[t5][8 * k2 + 4], S[t5][8 * k2 + 5]); pw.w = pk2(S[t5][8 * k2 + 6], S[t5][8 * k2 + 7]);
                const bf16x8 pb = __builtin_bit_cast(bf16x8, pw);
#pragma unroll
                for (int dt = 0; dt < 2; ++dt) { const LAS unsigned short* vr = Vt + (32 * dt + r32) * VROW + kb;
                    const v2u lo = *(const LAS v2u*)vr, hh = *(const LAS v2u*)(vr + 8);
                    const v4u vw = (v4u){lo.x, lo.y, hh.x, hh.y};
                    O[dt] = __builtin_amdgcn_mfma_f32_32x32x16_bf16(__builtin_bit_cast(bf16x8, vw), pb, O[dt], 0, 0, 0); } }
        const float inv = 1.0f / l; float sq = 0.f;
        bf16* orow = mixed + qrow * MIXW + 1024 + head * 64;
#pragma unroll
        for (int dt = 0; dt < 2; ++dt)
#pragma unroll
            for (int g4 = 0; g4 < 4; ++g4) { const float o0 = O[dt][4 * g4] * inv, o1 = O[dt][4 * g4 + 1] * inv, o2 = O[dt][4 * g4 + 2] * inv, o3 = O[dt][4 * g4 + 3] * inv;
                sq += (o0 * o0 + o1 * o1) + (o2 * o2 + o3 * o3);
                v2u w; w.x = pk2(o0, o1); w.y = pk2(o2, o3); *(v2u*)(orow + 32 * dt + 8 * g4 + 4 * hi) = w; }
        sq += __shfl_xor(sq, 32);
        if (hi == 0) ssq_attn[qrow * 16 + head] = sq;
    }
}

__device__ __forceinline__ float sigm(float z) { return __builtin_amdgcn_rcpf(1.0f + __builtin_amdgcn_exp2f(-z * LOG2E)); }
__device__ __forceinline__ void lru_load_x(bf16x8 (&xr)[2][4], const bf16* xcol, size_t rowb, int t) {
#pragma unroll
    for (int tap = 0; tap < 4; ++tap) { const int tt = t - 3 + tap;
#pragma unroll
        for (int ks = 0; ks < 2; ++ks) { bf16x8 v = (bf16x8){0, 0, 0, 0, 0, 0, 0, 0}; if (tt >= 0) v = *(const bf16x8*)(xcol + (rowb + tt) * INW + 32 * ks); xr[ks][tap] = v; } }
}
__device__ __forceinline__ void lru_unit(LAS unsigned char* lds, int b, int n, int half, const bf16* proj, const bf16* WgA, const bf16* WgX, const float* conv_w, const float* conv_b,
                                         const float* b_a, const float* b_x, const float* lam, bf16* mixed, float* ssq_lru) {
    const int tid = threadIdx.x, lane = tid & 63, wave = tid >> 6, fr = lane & 15, fq = lane >> 4;
    LAS float* cwl = (LAS float*)lds;
    LAS float* exch = (LAS float*)(lds + 2048);
    LAS float* xcs = (LAS float*)(lds + 8192) + wave * (16 * 36);
    __syncthreads();
    if (tid < 320) { const int tap = tid >> 6, c = tid & 63; cwl[tid] = tap < 4 ? conv_w[tap * 1024 + n * 64 + c] : conv_b[n * 64 + c]; }
    __syncthreads();
    bf16x8 wa[2][2], wx[2][2]; float ba[2], bx[2], c1[2], hc[2];
#pragma unroll
    for (int nt = 0; nt < 2; ++nt) { const int dl = 32 * half + 16 * nt + fr, ch = n * 64 + dl;
#pragma unroll
        for (int ks = 0; ks < 2; ++ks) { const size_t idx = (size_t)(n * 64 + dl) * 64 + 32 * ks + 8 * fq; wa[nt][ks] = *(const bf16x8*)(WgA + idx); wx[nt][ks] = *(const bf16x8*)(WgX + idx); }
        ba[nt] = b_a[ch]; bx[nt] = b_x[ch]; const float L = lam[ch];
        const float sp = (L < -20.f) ? -L : log1pf(expf(-L));
        c1[nt] = -8.0f * sp * LOG2E; hc[nt] = 0.f; }
    const size_t rowb = (size_t)b * SEQ;
    const bf16* xcol = proj + n * 64 + 8 * fq;
    bf16x8 xcur[2][4];
    lru_load_x(xcur, xcol, rowb, wave * 16 + fr);
#pragma unroll 1
    for (int chunk = 0; chunk < 16; ++chunk) {
        const int tb = chunk * 128 + wave * 16;
        bf16x8 xnext[2][4];
        { const int cn = chunk < 15 ? chunk + 1 : 15; lru_load_x(xnext, xcol, rowb, cn * 128 + wave * 16 + fr); }
        unsigned short gv[2][4];
#pragma unroll
        for (int nt = 0; nt < 2; ++nt)
#pragma unroll
            for (int i = 0; i < 4; ++i) gv[nt][i] = proj[(rowb + tb + 4 * fq + i) * INW + OFF_G + n * 64 + 32 * half + 16 * nt + fr];
        float xc[2][8];
#pragma unroll
        for (int ks = 0; ks < 2; ++ks) {
            const f32x4 b0 = *(const LAS f32x4*)(cwl + 256 + 32 * ks + 8 * fq), b1 = *(const LAS f32x4*)(cwl + 256 + 32 * ks + 8 * fq + 4);
#pragma unroll
            for (int e = 0; e < 4; ++e) { xc[ks][e] = b0[e]; xc[ks][4 + e] = b1[e]; }
#pragma unroll
            for (int tap = 0; tap < 4; ++tap) { const f32x4 w0 = *(const LAS f32x4*)(cwl + tap * 64 + 32 * ks + 8 * fq), w1 = *(const LAS f32x4*)(cwl + tap * 64 + 32 * ks + 8 * fq + 4);
#pragma unroll
                for (int e = 0; e < 4; ++e) { xc[ks][e] += w0[e] * bf2f((unsigned short)xcur[ks][tap][e]); xc[ks][4 + e] += w1[e] * bf2f((unsigned short)xcur[ks][tap][4 + e]); } } }
        bf16x8 af[2];
#pragma unroll
        for (int ks = 0; ks < 2; ++ks) { v4u w; w.x = pk2(xc[ks][0], xc[ks][1]); w.y = pk2(xc[ks][2], xc[ks][3]); w.z = pk2(xc[ks][4], xc[ks][5]); w.w = pk2(xc[ks][6], xc[ks][7]); af[ks] = __builtin_bit_cast(bf16x8, w); }
        f32x4 ra[2], ia[2];
#pragma unroll
        for (int nt = 0; nt < 2; ++nt) { ra[nt] = (f32x4){0.f, 0.f, 0.f, 0.f}; ia[nt] = (f32x4){0.f, 0.f, 0.f, 0.f};
#pragma unroll
            for (int ks = 0; ks < 2; ++ks) { ra[nt] = __builtin_amdgcn_mfma_f32_16x16x32_bf16(af[ks], wa[nt][ks], ra[nt], 0, 0, 0); ia[nt] = __builtin_amdgcn_mfma_f32_16x16x32_bf16(af[ks], wx[nt][ks], ia[nt], 0, 0, 0); } }
        { const int ks = half; LAS float* wp = xcs + fr * 36 + 8 * fq;
          *(LAS f32x4*)wp = (f32x4){xc[ks][0], xc[ks][1], xc[ks][2], xc[ks][3]}; *(LAS f32x4*)(wp + 4) = (f32x4){xc[ks][4], xc[ks][5], xc[ks][6], xc[ks][7]}; }
        __builtin_amdgcn_wave_barrier(); asm volatile("s_waitcnt lgkmcnt(0)" ::: "memory");
        float Al[2][4], Hl[2][4], Ai[2], Hi[2];
#pragma unroll
        for (int nt = 0; nt < 2; ++nt) { float a_run = 1.f, h_run = 0.f;
#pragma unroll
            for (int i = 0; i < 4; ++i) { const float xv = xcs[(4 * fq + i) * 36 + 16 * nt + fr];
                const float r = sigm(ra[nt][i] + ba[nt]), ig = sigm(ia[nt][i] + bx[nt]);
                const float la2 = c1[nt] * r, a = __builtin_amdgcn_exp2f(la2);
                const float x2 = la2 * (2.0f * 0.6931471805599453f);
                const float em = (x2 > -0.03f) ? -x2 * (1.0f + x2 * (0.5f + x2 * (0.16666667f + x2 * 0.041666668f))) : 1.0f - a * a;
                const float bt = __builtin_amdgcn_sqrtf(em) * (ig * xv);
                h_run = a * h_run + bt; a_run *= a; Al[nt][i] = a_run; Hl[nt][i] = h_run; }
            float A = a_run, H = h_run;
            { const float Ap = __shfl_up(A, 16), Hp = __shfl_up(H, 16); if (fq >= 1) { H = A * Hp + H; A = A * Ap; } }
            { const float Ap = __shfl_up(A, 32), Hp = __shfl_up(H, 32); if (fq >= 2) { H = A * Hp + H; A = A * Ap; } }
            Ai[nt] = A; Hi[nt] = H; }
        __builtin_amdgcn_wave_barrier();
        const int buf = chunk & 1;
        if (fq == 3) {
#pragma unroll
            for (int nt = 0; nt < 2; ++nt) { LAS float* e = exch + ((buf * 8 + wave) * 32 + nt * 16 + fr) * 2; e[0] = Ai[nt]; e[1] = Hi[nt]; } }
        __syncthreads();
        float sq[4] = {0.f, 0.f, 0.f, 0.f}; float yv[2][4];
#pragma unroll
        for (int nt = 0; nt < 2; ++nt) {
            float hw = hc[nt], hin_w = 0.f;
#pragma unroll
            for (int w = 0; w < 8; ++w) { const LAS float* e = exch + ((buf * 8 + w) * 32 + nt * 16 + fr) * 2; const float Aw = e[0], Hw = e[1]; if (w == wave) hin_w = hw; hw = Aw * hw + Hw; }
            hc[nt] = hw;
            float Aex = __shfl_up(Ai[nt], 16), Hex = __shfl_up(Hi[nt], 16); if (fq == 0) { Aex = 1.f; Hex = 0.f; }
            const float hin = Aex * hin_w + Hex;
#pragma unroll
            for (int i = 0; i < 4; ++i) { const float h = Hl[nt][i] + Al[nt][i] * hin; const float g = bf2f(gv[nt][i]);
                const float u2 = 1.5957691216057308f * (g + 0.044715f * g * g * g);
                const float y = h * g * sigm(u2); yv[nt][i] = y; sq[i] += y * y; } }
#pragma unroll
        for (int i = 0; i < 4; ++i) { float s = sq[i]; s += __shfl_xor(s, 1); s += __shfl_xor(s, 2); s += __shfl_xor(s, 4); s += __shfl_xor(s, 8);
            const size_t row = rowb + tb + 4 * fq + i;
            if (fr == 0) ssq_lru[row * 32 + n * 2 + half] = s;
#pragma unroll
            for (int nt = 0; nt < 2; ++nt) { bf16 hb = (bf16)(pk2(yv[nt][i], 0.f) & 0xffffu); mixed[row * MIXW + n * 64 + 32 * half + 16 * nt + fr] = hb; } }
#pragma unroll
        for (int ks = 0; ks < 2; ++ks)
#pragma unroll
            for (int tap = 0; tap < 4; ++tap) xcur[ks][tap] = xnext[ks][tap];
    }
}

#define XB_TMO      128
#define XB_XCNT(j)  (256  + 64 * (j))
#define XB_XSUB(j)  (1280 + 64 * (j))
#define XB_XGEN(j)  (2304 + 64 * (j))
#define XB_TOP      3328
#define XB_TOPGEN   3392
#define XCD_BAR_WORDS 3456
#define XB_SPIN_CAP (1u << 18)

__device__ __forceinline__ unsigned xb_ld(unsigned* p)              { return __hip_atomic_load(p, __ATOMIC_RELAXED, __HIP_MEMORY_SCOPE_AGENT); }
__device__ __forceinline__ unsigned xb_add(unsigned* p, unsigned v) { return __hip_atomic_fetch_add(p, v, __ATOMIC_RELAXED, __HIP_MEMORY_SCOPE_AGENT); }
__device__ __forceinline__ unsigned xb_xcc_id() { return (unsigned)__builtin_amdgcn_s_getreg((3 << 11) | 20) & 0xFu; }
#define XB_SPIN(cond, bar) do { unsigned _sp = 0; while (cond) { __builtin_amdgcn_s_sleep(1); \
    if ((++_sp & 255u) == 0u) { if (xb_ld(&(bar)[XB_TMO])) break; if (_sp > XB_SPIN_CAP) { atomicAdd(&(bar)[XB_TMO], 1u); break; } } } } while (0)

struct XcdBarrier {
    unsigned* bar; unsigned x;
    volatile LAS unsigned* st;
};

__device__ __forceinline__ XcdBarrier xcd_barrier_post(unsigned* bar, volatile LAS unsigned* st) {
    XcdBarrier b; b.bar = bar; b.x = xb_xcc_id(); b.st = st;
    if (threadIdx.x == 0) (void)xb_add(&bar[XB_XCNT(b.x)], 1u);
    return b;
}
__device__ __forceinline__ void xcd_barrier_complete(unsigned* bar, unsigned x, unsigned& nloc, unsigned& nx) {
    const unsigned G = gridDim.x * gridDim.y * gridDim.z;
    unsigned sum, cnt, mine, sp = 0u;
    for (;;) {
        sum = 0u; cnt = 0u; mine = 0u;
#pragma unroll
        for (unsigned j = 0; j < 16; ++j) { const unsigned c = xb_ld(&bar[XB_XCNT(j)]); sum += c; cnt += (c > 0u) ? 1u : 0u; mine = (j == x) ? c : mine; }
        if (sum == G) break;
        __builtin_amdgcn_s_sleep(1);
        if ((++sp & 255u) == 0u) { if (xb_ld(&bar[XB_TMO])) break; if (sp > XB_SPIN_CAP) { atomicAdd(&bar[XB_TMO], 1u); break; } }
    }
    nloc = mine > 0u ? mine : 1u; nx = cnt > 0u ? cnt : 1u;
}

__device__ __forceinline__ void xcd_barrier(const XcdBarrier& b) {
    asm volatile("s_waitcnt vmcnt(0)" ::: "memory");
    __syncthreads();
    if (threadIdx.x == 0) {
        unsigned* bar = b.bar;
        __builtin_amdgcn_s_waitcnt(0);
        unsigned nloc = b.st[0], nx = b.st[1];
        if (nloc == 0u) { xcd_barrier_complete(bar, b.x, nloc, nx); b.st[0] = nloc; b.st[1] = nx; }
        const unsigned old = xb_add(&bar[XB_XSUB(b.x)], 1u);
        const unsigned gen = old / nloc;
        if (old + 1u == (gen + 1u) * nloc) {
            __builtin_amdgcn_fence(__ATOMIC_RELEASE, "agent");
            asm volatile("s_waitcnt vmcnt(0)" ::: "memory");
            const unsigned og = xb_add(&bar[XB_TOP], 1u);
            const unsigned tg = og / nx;
            if (og + 1u == (tg + 1u) * nx) xb_add(&bar[XB_TOPGEN], 1u);
            else XB_SPIN(xb_ld(&bar[XB_TOPGEN]) == tg, bar);
            __builtin_amdgcn_fence(__ATOMIC_ACQUIRE, "agent");
            xb_add(&bar[XB_XGEN(b.x)], 1u);
            asm volatile("s_waitcnt vmcnt(0)" ::: "memory");
        } else {
            XB_SPIN(xb_ld(&bar[XB_XGEN(b.x)]) == gen, bar);
            __builtin_amdgcn_fence(__ATOMIC_ACQUIRE, "agent");
            asm volatile("s_waitcnt vmcnt(0)" ::: "memory");
        }
    }
    __syncthreads();
}

__global__ void __launch_bounds__(NWAVES * 64, 2) fwd_megakernel(Args args) {
    extern __shared__ __attribute__((aligned(16))) unsigned char lds_raw[];
    LAS unsigned char* lds = (LAS unsigned char*)lds_raw;
    cg::grid_group grid = cg::this_grid();
    const int tid = threadIdx.x, lane = tid & 63, wave = __builtin_amdgcn_readfirstlane(tid >> 6);
    const int G = gridDim.x, bx = blockIdx.x, vcu = (G % 8 == 0) ? (bx % 8) * (G / 8) + bx / 8 : bx;
    unsigned char* ws = args.ws;
    bf16* HN = (bf16*)(ws + WS_HN); bf16* PROJ = (bf16*)(ws + WS_PROJ); bf16* MIX = (bf16*)(ws + WS_MIX); bf16* HB = (bf16*)(ws + WS_H);
    float* SSQ_LRU = (float*)(ws + WS_SSQ_LRU); float* SSQ_ATT = (float*)(ws + WS_SSQ_ATT); float* SSQ_X1 = (float*)(ws + WS_SSQ_X1); float* SSQ_X2 = (float*)(ws + WS_SSQ_X2);

    unsigned* barw = (unsigned*)ws;
    if (bx == 0) for (int i = tid; i < XCD_BAR_WORDS; i += NWAVES * 64) __hip_atomic_store(barw + i, 0u, __ATOMIC_RELAXED, __HIP_MEMORY_SCOPE_AGENT);
    volatile LAS unsigned* bst = (volatile LAS unsigned*)(lds + 140000);
    if (tid == 0) { bst[0] = 0u; bst[1] = 0u; }
    __threadfence();
    __syncthreads();
    p0_prologue(args, lds, vcu, G, wave, lane);
    grid.sync();
    const XcdBarrier xbar = xcd_barrier_post(barw, bst);

    { pg8::Gemm g{HN, (const bf16*)(ws + WS_WIN), M, INW, DM}; pg8::StaticOrder S; S.init(M, INW, G, bx);
      pg8::EpiProj E{PROJ, INW, QSCALE};
      pg8::gemm_phase<pg8::EpiProj, pg8::StaticOrder, true, true>(lds, g, S, E); }
    xcd_barrier(xbar);

    for (int u = vcu; u < 256; u += G) attn_unit(lds, u >> 5, (u >> 1) & 15, u & 1, PROJ, args.in[10], MIX, SSQ_ATT);
    for (int u = vcu; u < 256; u += G) lru_unit(lds, u >> 5, (u >> 1) & 15, u & 1, PROJ, (const bf16*)(ws + WS_WG), (const bf16*)(ws + WS_WG) + 65536, args.in[3], args.in[4], args.in[6], args.in[8], args.in[9], MIX, SSQ_LRU);
    xcd_barrier(xbar);

    { pg8::Gemm g{MIX, (const bf16*)(ws + WS_WOUT), M, DM, MIXW}; pg8::StaticOrder S; S.init(M, DM, G, bx);
      LAS float* ratio = (LAS float*)(lds + TAB_OFF); LAS float* rsl = ratio + 256;
      pg8::Unit u0; const bool has = S.next(0, u0);
      __syncthreads();
      if (has && tid < 256) { const size_t row = (size_t)u0.pm * 256 + tid; float sl = 0.f, sa = 0.f;
          const f32x4* pl = (const f32x4*)(SSQ_LRU + row * 32); const f32x4* pa = (const f32x4*)(SSQ_ATT + row * 16);
#pragma unroll
          for (int i = 0; i < 8; ++i) { const f32x4 v = pl[i]; sl += (v[0] + v[1]) + (v[2] + v[3]); }
#pragma unroll
          for (int i = 0; i < 4; ++i) { const f32x4 v = pa[i]; sa += (v[0] + v[1]) + (v[2] + v[3]); }
          const float rl = 1.0f / sqrtf(sl * (1.f / 1024.f) + 1e-6f), ra = 1.0f / sqrtf(sa * (1.f / 1024.f) + 1e-6f);
          ratio[tid] = rl / ra; rsl[tid] = ra; }
      __syncthreads();
      typedef pg8::EpiRes<true, true> EO;
      EO E{args.in[0], args.out, HN, SSQ_X1, ratio, rsl};
      pg8::gemm_phase<EO, pg8::StaticOrder, false, true>(lds, g, S, E); }
    xcd_barrier(xbar);

    { pg8::Gemm g{HN, (const bf16*)(ws + WS_WUP), M, FF, DM}; pg8::StaticOrder S; S.init(M, FF, G, bx);
      pg8::EpiUp E{HB, FF, SSQ_X1};
      pg8::gemm_phase<pg8::EpiUp, pg8::StaticOrder, true, true>(lds, g, S, E); }
    xcd_barrier(xbar);

    { pg8::Gemm g{HB, (const bf16*)(ws + WS_WDN), M, DM, FF}; pg8::StaticOrder S; S.init(M, DM, G, bx);
      typedef pg8::EpiRes<false, false> ED;
      ED E{args.out, args.out, nullptr, SSQ_X2, nullptr, nullptr};
      pg8::gemm_phase<ED, pg8::StaticOrder, false, true>(lds, g, S, E); }
    xcd_barrier(xbar);

    { const int gw = vcu * NWAVES + wave, NGW = G * NWAVES; const f32x4* gp = (const f32x4*)args.in[17] + lane;
      for (int m = gw; m < M; m += NGW) { const f32x4 p = *(const f32x4*)(SSQ_X2 + (size_t)m * 4);
          const float rs = 1.0f / sqrtf(((p[0] + p[1]) + (p[2] + p[3])) * (1.f / DM) + 1e-6f);
          f32x4* xr = (f32x4*)(args.out + (size_t)m * DM) + lane;
#pragma unroll
          for (int j = 0; j < 4; ++j) { const f32x4 v = xr[64 * j], g4 = gp[64 * j]; xr[64 * j] = v * rs * g4; } } }
}

extern "C" void kernel_launch(void* const* d_in, const int* in_sizes, int n_in, void* d_out, int out_size, void* d_ws, size_t ws_size, hipStream_t stream) {
    static int grid = 0;
    if (grid == 0) {
        int dev = 0, cus = 0, per_cu = 0;
        (void)hipGetDevice(&dev); (void)hipDeviceGetAttribute(&cus, hipDeviceAttributeMultiprocessorCount, dev);
        if (hipFuncSetAttribute((const void*)fwd_megakernel, hipFuncAttributeMaxDynamicSharedMemorySize, LDS_BYTES) != hipSuccess) fprintf(stderr, "kernel_launch: hipFuncSetAttribute failed\n");
        if (hipOccupancyMaxActiveBlocksPerMultiprocessor(&per_cu, (const void*)fwd_megakernel, NWAVES * 64, LDS_BYTES) != hipSuccess || per_cu < 1) per_cu = 1;
        (void)hipGetLastError();
        grid = cus * per_cu; if (grid > 256) grid = 256; if (grid < 1) grid = 256;
        if (n_in != 18 || ws_size < WS_END) fprintf(stderr, "kernel_launch: unexpected n_in %d / ws %zu\n", n_in, ws_size);
    }
    Args a{};
    for (int i = 0; i < 18; ++i) a.in[i] = (const float*)d_in[i];
    a.out = (float*)d_out; a.ws = (unsigned char*)d_ws;
    void* kargs[] = {&a};
    hipError_t e = hipLaunchCooperativeKernel((const void*)fwd_megakernel, dim3(grid), dim3(NWAVES * 64), kargs, LDS_BYTES, stream);
    if (e != hipSuccess) fprintf(stderr, "cooperative launch failed: %s (grid %d)\n", hipGetErrorString(e), grid);
}
```

```cpp
#include <hip/hip_runtime.h>
#include <hip/hip_cooperative_groups.h>
#include <cstdio>
#include <cstdint>
namespace cg = cooperative_groups;
namespace pg8 {
#define PG8_LAS __attribute__((address_space(3)))
typedef unsigned short bf16_t;
typedef short bf16x8 __attribute__((ext_vector_type(8)));
typedef float f32x4 __attribute__((ext_vector_type(4)));
typedef unsigned u32x4 __attribute__((ext_vector_type(4)));
constexpr int BM = 256, BK = 64, HALF = 128, HTB = HALF * BK * 2  , STAGE_BYTES = 8 * HTB, NXCD = 8, WGM = 8;

__host__ __device__ __forceinline__ int lds_byte(int r, int c) { const int st = (r >> 4) * 2 + (c >> 5), rr = r & 15, cc = c & 31, ob = rr * 64 + cc * 2; return st * 1024 + (ob ^ (((ob >> 9) & 1) << 5)); }
__host__ __device__ __forceinline__ void stage_rc(int b, int& R, int& C) { const int st = b / 1024, sb = b % 1024, swz = sb ^ (((sb >> 9) & 1) << 5); R = (st >> 1) * 16 + swz / 64; C = (st & 1) * 32 + (swz % 64) / 2; }
__host__ __device__ __forceinline__ int perm32(int rho) { const int n = rho >> 4, i = rho & 15; return 8 * (i >> 2) + 4 * n + (i & 3); }

struct Unit { int pm, pn; };
struct Gemm { const bf16_t* A; const bf16_t* Bt; int M, N, K; };

struct StaticOrder {
    int nM, nN, nwg, G, c;
    __host__ __device__ void init(int M, int N, int G_, int c_) { nM = M / BM; nN = N / BM; nwg = nM * nN; G = G_; c = c_; }
    __host__ __device__ bool next(int i, Unit& u) const {
        const long L = (long)i * G + c; if (L >= nwg) return false;
        int wgid = (int)L; { const int q = nwg / NXCD, r = nwg % NXCD, xcd = wgid % NXCD, off = wgid / NXCD; wgid = (xcd < r ? xcd * (q + 1) : r * (q + 1) + (xcd - r) * q) + off; }
        const int nig = WGM * nN, gid = wgid / nig, fm = gid * WGM, gsz = (nM - fm) < WGM ? (nM - fm) : WGM;
        u.pm = fm + ((wgid % nig) % gsz); u.pn = (wgid % nig) / gsz; return true;
    }
    __device__ __forceinline__ void a_ready(const Unit&) const {}
    __device__ __forceinline__ void done(const Unit&) const {}
};

__device__ __forceinline__ unsigned cvt_pk_bf16(float lo, float hi) { unsigned r; asm volatile("v_cvt_pk_bf16_f32 %0, %1, %2" : "=v"(r) : "v"(lo), "v"(hi)); return r; }
typedef float f32x2 __attribute__((ext_vector_type(2)));
constexpr float RMS_EPS = 1e-6f;
__device__ __forceinline__ u32x4 pack8(f32x4 v0, f32x4 v1) { u32x4 w; w.x = cvt_pk_bf16(v0[0], v0[1]); w.y = cvt_pk_bf16(v0[2], v0[3]); w.z = cvt_pk_bf16(v1[0], v1[1]); w.w = cvt_pk_bf16(v1[2], v1[3]); return w; }

struct EpiProj {
    static constexpr bool PERM = true, AFTER_DRAIN = false, MIDK = false;
    bf16_t* O; int ldc; float qscale;
    __device__ __forceinline__ void midk(f32x4 (&)[2][2][4][2], int, int) const {}
    __device__ __forceinline__ void operator()(const f32x4 (&acc)[2][2][4][2], const Unit& u, int wr, int wc, int fr, int fq) const {
        const int row0 = u.pm * BM + wr * 64 + fr, col0 = u.pn * BM + wc * 32 + 8 * fq;
        const float sc = (u.pn >= 8 && u.pn < 12) ? qscale : 1.f;
#pragma unroll
        for (int ai = 0; ai < 2; ++ai)
#pragma unroll
            for (int m = 0; m < 4; ++m) { bf16_t* rowp = O + (size_t)(row0 + ai * HALF + m * 16) * ldc + col0;
#pragma unroll
                for (int bj = 0; bj < 2; ++bj) *(u32x4*)(rowp + bj * HALF) = pack8(acc[ai][bj][m][0] * sc, acc[ai][bj][m][1] * sc); }
    }
};
struct EpiUp {
    static constexpr bool PERM = true, AFTER_DRAIN = false, MIDK = false;
    bf16_t* O; int ldc; const float* ssq;
    __device__ __forceinline__ void midk(f32x4 (&)[2][2][4][2], int, int) const {}
    __device__ __forceinline__ void operator()(const f32x4 (&acc)[2][2][4][2], const Unit& u, int wr, int wc, int fr, int fq) const {
        const int row0 = u.pm * BM + wr * 64 + fr, col0 = u.pn * BM + wc * 32 + 8 * fq;
#pragma unroll
        for (int ai = 0; ai < 2; ++ai)
#pragma unroll
            for (int m = 0; m < 4; ++m) { const int row = row0 + ai * HALF + m * 16; const f32x4 p = *(const f32x4*)(ssq + (size_t)row * 4);
                const float rs = __builtin_amdgcn_rsqf(((p[0] + p[1]) + (p[2] + p[3])) * (1.0f / 1024.0f) + RMS_EPS);
                bf16_t* rowp = O + (size_t)row * ldc + col0;
#pragma unroll
                for (int bj = 0; bj < 2; ++bj) { f32x4 v0 = acc[ai][bj][m][0] * rs, v1 = acc[ai][bj][m][1] * rs;
#pragma unroll
                    for (int e = 0; e < 4; ++e) { const float a = fmaxf(v0[e], 0.f), b = fmaxf(v1[e], 0.f); v0[e] = a * a; v1[e] = b * b; }
                    *(u32x4*)(rowp + bj * HALF) = pack8(v0, v1); } }
    }
};
template <bool HAS_MIDK, bool HAS_B16> struct EpiRes {
    static constexpr bool PERM = true, AFTER_DRAIN = true, MIDK = HAS_MIDK;
    const float* base; float* out; bf16_t* ob; float* ssq; const PG8_LAS float* ratio; const PG8_LAS float* rsl;
    __device__ __forceinline__ void midk(f32x4 (&acc)[2][2][4][2], int wr, int fr) const {
#pragma unroll
        for (int ai = 0; ai < 2; ++ai)
#pragma unroll
            for (int m = 0; m < 4; ++m) { const float f = ratio[ai * HALF + wr * 64 + m * 16 + fr];
#pragma unroll
                for (int bj = 0; bj < 2; ++bj) { acc[ai][bj][m][0] = acc[ai][bj][m][0] * f; acc[ai][bj][m][1] = acc[ai][bj][m][1] * f; } }
    }
    __device__ __forceinline__ void fused(f32x4 (&acc)[2][2][4][2], const Unit& u, int wr, int wc, int fr, int fq, PG8_LAS unsigned char* lds, int wid, int lane) const {
        PG8_LAS float* P = (PG8_LAS float*)lds;
#pragma unroll
        for (int ai = 0; ai < 2; ++ai)
#pragma unroll
            for (int m = 0; m < 4; ++m) { const int r = ai * HALF + wr * 64 + m * 16 + fr; const size_t row = (size_t)u.pm * BM + r;
                const float rs = HAS_MIDK ? rsl[r] : 1.f; float s = 0.f;
#pragma unroll
                for (int bj = 0; bj < 2; ++bj) { const size_t off = row * 1024 + u.pn * BM + bj * HALF + wc * 32 + 8 * fq;
                    const f32x4 xa = *(const f32x4*)(base + off), xb = *(const f32x4*)(base + off + 4);
                    const f32x4 v0 = xa + acc[ai][bj][m][0] * rs, v1 = xb + acc[ai][bj][m][1] * rs;
                    *(f32x4*)(out + off) = v0; *(f32x4*)(out + off + 4) = v1;
                    if (HAS_B16) *(u32x4*)(ob + off) = pack8(v0, v1);
                    s += (v0[0] * v0[0] + v0[1] * v0[1]) + (v0[2] * v0[2] + v0[3] * v0[3]) + (v1[0] * v1[0] + v1[1] * v1[1]) + (v1[2] * v1[2] + v1[3] * v1[3]); }
                s += __shfl_xor(s, 16); s += __shfl_xor(s, 32);
                if (fq == 0) P[r * 4 + wc] = s; }
        __syncthreads();
        const int t = wid * 64 + lane;
        if (t < 256) { const float s = (P[t * 4] + P[t * 4 + 1]) + (P[t * 4 + 2] + P[t * 4 + 3]); ssq[((size_t)u.pm * BM + t) * 4 + u.pn] = s; }
    }
};

template <class Epi, class Sched, bool ALIGN_EPI = false, bool SP2 = false>
__device__ __forceinline__ void gemm_phase(PG8_LAS unsigned char* lds, const Gemm g, const Sched& S, const Epi& E) {
    const int tid = threadIdx.x, wid = __builtin_amdgcn_readfirstlane(tid >> 6), lane = tid & 63, wr = wid >> 2, wc = wid & 3, fr = lane & 15, fq = lane >> 4;
    const int K = g.K, nt = K / BK;
    unsigned voffA[2], voffB[2];
#pragma unroll
    for (int i = 0; i < 2; ++i) { int R, C; stage_rc(tid * 16 + i * 8192, R, C); const int Rb = Epi::PERM ? ((R & ~31) + perm32(R & 31)) : R;
        voffA[i] = (unsigned)(R * K + C) * 2u; voffB[i] = (unsigned)(Rb * K + C) * 2u; }
    const size_t kstep = (size_t)(BK * 2);
    const size_t hstep = (size_t)HALF * K * 2;
    const size_t tstep = 2 * hstep;
    const unsigned ldsw = (unsigned)wid * 1024u;
    const int aoff = lds_byte(wr * 64 + fr, fq * 8), boff = lds_byte(wc * 32 + fr, fq * 8);
#define PG8_SA(b, h) (((b) * 2 + (h)) * HTB)
#define PG8_SB(b, h) ((4 + (b) * 2 + (h)) * HTB)
#define PG8_STAGE(bufoff, gbase, voff) do { _Pragma("unroll") for (int _i = 0; _i < 2; ++_i) \
        __builtin_amdgcn_global_load_lds((const unsigned*)((const char*)(gbase) + (voff)[_i]), (PG8_LAS unsigned*)(lds + (bufoff) + ldsw + _i * 8192), 16, 0, 0); } while (0)
#define PG8_LDA(dst, b, h) do { _Pragma("unroll") for (int m = 0; m < 4; ++m) _Pragma("unroll") for (int k = 0; k < 2; ++k) dst[m][k] = *(const PG8_LAS bf16x8*)(lds + PG8_SA(b, h) + aoff + m * 2048 + k * 1024); } while (0)
#define PG8_LDB(dst, b, h) do { _Pragma("unroll") for (int n = 0; n < 2; ++n) _Pragma("unroll") for (int k = 0; k < 2; ++k) dst[n][k] = *(const PG8_LAS bf16x8*)(lds + PG8_SB(b, h) + boff + n * 2048 + k * 1024); } while (0)
#define PG8_MMA(ai, bj, At, Bt) do { __builtin_amdgcn_s_setprio(1); _Pragma("unroll") for (int m = 0; m < 4; ++m) _Pragma("unroll") for (int n = 0; n < 2; ++n) _Pragma("unroll") for (int k = 0; k < 2; ++k) \
        acc[ai][bj][m][n] = __builtin_amdgcn_mfma_f32_16x16x32_bf16(Bt[n][k], At[m][k], acc[ai][bj][m][n], 0, 0, 0); __builtin_amdgcn_s_setprio(0); } while (0)
#define PG8_WAIT_V(n) asm volatile("s_waitcnt vmcnt(" #n ")" ::: "memory")
#define PG8_WAIT_L(n) asm volatile("s_waitcnt lgkmcnt(" #n ")" ::: "memory")
#define PG8_BAR __builtin_amdgcn_s_barrier()
#define PG8_SCHED __builtin_amdgcn_sched_barrier(0)
    Unit cur, nxt; int ui = 0;
    if (!S.next(0, cur)) return;
    f32x4 acc[2][2][4][2];
#pragma unroll
    for (int a = 0; a < 2; ++a)
#pragma unroll
        for (int b = 0; b < 2; ++b)
#pragma unroll
            for (int m = 0; m < 4; ++m)
#pragma unroll
                for (int n = 0; n < 2; ++n) acc[a][b][m][n] = (f32x4){0.f, 0.f, 0.f, 0.f};
    bf16x8 At[4][2], B0[2][2], B1[2][2];
    const char* cA = (const char*)g.A + (size_t)cur.pm * tstep; const char* cB = (const char*)g.Bt + (size_t)cur.pn * tstep;
    S.a_ready(cur);
    if constexpr (SP2) {
        PG8_STAGE(PG8_SB(0, 0), cB, voffB); PG8_STAGE(PG8_SB(0, 1), cB + hstep, voffB); PG8_STAGE(PG8_SA(0, 0), cA, voffA); PG8_STAGE(PG8_SA(0, 1), cA + hstep, voffA);
        if (wr == 1) PG8_BAR;
        PG8_WAIT_V(2); PG8_BAR;
        PG8_STAGE(PG8_SB(1, 0), cB + kstep, voffB); PG8_STAGE(PG8_SA(1, 0), cA + kstep, voffA); PG8_STAGE(PG8_SB(1, 1), cB + hstep + kstep, voffB);
        PG8_WAIT_V(6); PG8_BAR;
    } else {
        PG8_STAGE(PG8_SB(0, 0), cB, voffB); PG8_STAGE(PG8_SA(0, 0), cA, voffA); PG8_STAGE(PG8_SB(0, 1), cB + hstep, voffB); PG8_STAGE(PG8_SA(0, 1), cA + hstep, voffA);
        if (wr == 1) PG8_BAR;
        PG8_WAIT_V(4); PG8_BAR;
        PG8_STAGE(PG8_SB(1, 0), cB + kstep, voffB); PG8_STAGE(PG8_SA(1, 0), cA + kstep, voffA); PG8_STAGE(PG8_SB(1, 1), cB + hstep + kstep, voffB);
        PG8_WAIT_V(6); PG8_BAR;
    }
    for (;;) {
        const bool has_next = S.next(ui + 1, nxt);
        const char* nA = has_next ? (const char*)g.A + (size_t)nxt.pm * tstep : cA; const char* nB = has_next ? (const char*)g.Bt + (size_t)nxt.pn * tstep : cB;
        for (int t = 0; t < nt; t += 2) {
            const bool last = (t == nt - 2);
            const char* a1 = cA + (size_t)(t + 1) * kstep;
            const char* a2 = last ? nA : cA + (size_t)(t + 2) * kstep; const char* b2 = last ? nB : cB + (size_t)(t + 2) * kstep;
            const char* a3 = a2 + kstep; const char* b3 = b2 + kstep;
            if (last && has_next) S.a_ready(nxt);
            if constexpr (Epi::MIDK) { if (t == nt / 2) E.midk(acc, wr, fr); }
            if constexpr (SP2) {
            PG8_LDB(B0, 0, 0); PG8_LDB(B1, 0, 1); PG8_SCHED; PG8_LDA(At, 0, 0); PG8_STAGE(PG8_SA(1, 1), a1 + hstep, voffA);
            PG8_WAIT_V(8); PG8_WAIT_L(0); PG8_BAR; PG8_MMA(0, 0, At, B0); PG8_MMA(0, 1, At, B1); PG8_BAR; PG8_SCHED;
            PG8_LDA(At, 0, 1); PG8_STAGE(PG8_SB(0, 0), b2, voffB); PG8_STAGE(PG8_SB(0, 1), b2 + hstep, voffB); PG8_STAGE(PG8_SA(0, 0), a2, voffA);
            PG8_WAIT_V(8); PG8_WAIT_L(0); PG8_BAR; PG8_MMA(1, 0, At, B0); PG8_MMA(1, 1, At, B1); PG8_BAR; PG8_SCHED;
            PG8_LDB(B0, 1, 0); PG8_LDB(B1, 1, 1); PG8_SCHED; PG8_LDA(At, 1, 0); PG8_STAGE(PG8_SA(0, 1), a2 + hstep, voffA);
            PG8_WAIT_V(8); PG8_WAIT_L(0); PG8_BAR; PG8_MMA(0, 0, At, B0); PG8_MMA(0, 1, At, B1); PG8_BAR; PG8_SCHED;
            PG8_LDA(At, 1, 1); PG8_STAGE(PG8_SB(1, 0), b3, voffB); PG8_STAGE(PG8_SB(1, 1), b3 + hstep, voffB); PG8_STAGE(PG8_SA(1, 0), a3, voffA);
            PG8_WAIT_V(8); PG8_WAIT_L(0); PG8_BAR; PG8_MMA(1, 0, At, B0); PG8_MMA(1, 1, At, B1); PG8_BAR; PG8_SCHED;
            } else {
            PG8_LDB(B0, 0, 0); PG8_SCHED; PG8_LDA(At, 0, 0); PG8_STAGE(PG8_SA(1, 1), a1 + hstep, voffA);
            PG8_WAIT_L(8); PG8_BAR; PG8_WAIT_L(0); PG8_MMA(0, 0, At, B0); PG8_BAR; PG8_SCHED;
            PG8_LDB(B1, 0, 1); PG8_STAGE(PG8_SB(0, 0), b2, voffB);
            PG8_BAR; PG8_WAIT_L(0); PG8_MMA(0, 1, At, B1); PG8_BAR;
            PG8_LDA(At, 0, 1); PG8_STAGE(PG8_SA(0, 0), a2, voffA);
            PG8_BAR; PG8_WAIT_L(0); PG8_MMA(1, 0, At, B0); PG8_BAR; PG8_SCHED;
            PG8_STAGE(PG8_SB(0, 1), b2 + hstep, voffB);
            PG8_WAIT_V(6); PG8_BAR; PG8_MMA(1, 1, At, B1); PG8_BAR;
            PG8_LDB(B0, 1, 0); PG8_SCHED; PG8_LDA(At, 1, 0); PG8_STAGE(PG8_SA(0, 1), a2 + hstep, voffA);
            PG8_WAIT_L(8); PG8_BAR; PG8_WAIT_L(0); PG8_MMA(0, 0, At, B0); PG8_BAR; PG8_SCHED;
            PG8_LDB(B1, 1, 1); PG8_STAGE(PG8_SB(1, 0), b3, voffB);
            PG8_BAR; PG8_WAIT_L(0); PG8_MMA(0, 1, At, B1); PG8_BAR;
            PG8_LDA(At, 1, 1); PG8_STAGE(PG8_SA(1, 0), a3, voffA);
            PG8_BAR; PG8_WAIT_L(0); PG8_MMA(1, 0, At, B0); PG8_BAR; PG8_SCHED;
            PG8_STAGE(PG8_SB(1, 1), b3 + hstep, voffB);
            PG8_WAIT_V(6); PG8_BAR; PG8_MMA(1, 1, At, B1); PG8_BAR;
            }
        }
        if constexpr (ALIGN_EPI) { if (wr == 0) PG8_BAR; }
        if constexpr (!Epi::AFTER_DRAIN) { E(acc, cur, wr, wc, fr, fq); S.done(cur); }
        if (!has_next) break;
#pragma unroll
        for (int a = 0; a < 2; ++a)
#pragma unroll
            for (int b = 0; b < 2; ++b)
#pragma unroll
                for (int m = 0; m < 4; ++m)
#pragma unroll
                    for (int n = 0; n < 2; ++n) acc[a][b][m][n] = (f32x4){0.f, 0.f, 0.f, 0.f};
        cur = nxt; cA = nA; cB = nB; ++ui;
        if constexpr (ALIGN_EPI) { if (wr == 1) PG8_BAR; }
    }
    PG8_WAIT_V(0);
    if constexpr (!ALIGN_EPI) { if (wr == 0) PG8_BAR; }
    PG8_BAR;
    if constexpr (Epi::AFTER_DRAIN) { E.fused(acc, cur, wr, wc, fr, fq, lds, wid, lane); S.done(cur); }
#undef PG8_SA
#undef PG8_SB
#undef PG8_STAGE
#undef PG8_LDA
#undef PG8_LDB
#undef PG8_MMA
#undef PG8_WAIT_V
#undef PG8_WAIT_L
#undef PG8_BAR
#undef PG8_SCHED
}
}
constexpr int NB = 8, SEQ = 2048, DM = 1024, M = NB * SEQ, INW = 3328, MIXW = 2048, FF = 4096;
constexpr int OFF_G = 1024, OFF_Q = 2048, OFF_K = 3072, OFF_V = 3200;
constexpr float LOG2E = 1.4426950408889634f;
constexpr float QSCALE = 0.125f * LOG2E;
constexpr int NWAVES = 8;
constexpr size_t MiB = 1u << 20;
constexpr size_t WS_WIN = 1 * MiB, WS_WOUT = 8 * MiB, WS_WUP = 12 * MiB, WS_WDN = 20 * MiB, WS_WG = 28 * MiB;
constexpr size_t WS_SSQ_LRU = 29 * MiB  , WS_SSQ_ATT = 31 * MiB  ;
constexpr size_t WS_HN = 32 * MiB  , WS_PROJ = 64 * MiB  , WS_MIX = 168 * MiB  ;
constexpr size_t WS_H = 64 * MiB  ;
constexpr size_t WS_SSQ_X1 = 232 * MiB  , WS_SSQ_X2 = 233 * MiB, WS_END = 234 * MiB;
constexpr int RING_BYTES = 131072, TAB_OFF = RING_BYTES + 512, LDS_BYTES = 147456;

#define LAS __attribute__((address_space(3)))
typedef unsigned short bf16;
typedef unsigned v4u __attribute__((ext_vector_type(4)));
typedef unsigned v2u __attribute__((ext_vector_type(2)));
typedef float f32x4 __attribute__((ext_vector_type(4)));
typedef float f32x16 __attribute__((ext_vector_type(16)));
typedef short bf16x8 __attribute__((ext_vector_type(8)));
typedef short s16x4 __attribute__((ext_vector_type(4)));
__device__ __forceinline__ float bf2f(unsigned short h) { return __uint_as_float((unsigned)h << 16); }
__device__ __forceinline__ unsigned pk2(float lo, float hi) { return pg8::cvt_pk_bf16(lo, hi); }
__device__ __forceinline__ float wave_sum(float v) {
#pragma unroll
    for (int o = 1; o < 64; o <<= 1) v += __shfl_xor(v, o);
    return v;
}
__device__ __forceinline__ void p0_transpose_item(const float* W, int K, int N, bf16* WT, const float* gain, LAS float* scr, int item, int lane) {
    const int nblk = N / 32, kb = item / nblk, nb = item % nblk, k0 = 64 * kb, n0 = 32 * nb;
#pragma unroll 8
    for (int i = 0; i < 32; ++i) { const int kk = 2 * i + (lane >> 5); float v = W[(size_t)(k0 + kk) * N + n0 + (lane & 31)]; if (gain) v *= gain[k0 + kk]; scr[kk * 33 + (lane & 31)] = v; }
    asm volatile("s_waitcnt lgkmcnt(0)" ::: "memory");
    const int c = lane & 7;
#pragma unroll
    for (int j = 0; j < 4; ++j) { const int n = (lane >> 3) + 8 * j; const LAS float* s = scr + (8 * c) * 33 + n;
        v4u o; o.x = pk2(s[0 * 33], s[1 * 33]); o.y = pk2(s[2 * 33], s[3 * 33]); o.z = pk2(s[4 * 33], s[5 * 33]); o.w = pk2(s[6 * 33], s[7 * 33]);
        *(v4u*)(WT + (size_t)(n0 + n) * K + k0 + 8 * c) = o; }
    asm volatile("s_waitcnt lgkmcnt(0)" ::: "memory");
}
struct Args { const float* in[18]; float* out; unsigned char* ws; };

__device__ __forceinline__ void p0_prologue(const Args& A, LAS unsigned char* lds, int vcu, int G, int wave, int lane) {
    LAS float* scr = (LAS float*)(lds + wave * 16384);
    const int gw = vcu * NWAVES + wave, NGW = G * NWAVES;
    unsigned char* ws = A.ws;
    constexpr int I_IN = (DM / 64) * (INW / 32), I_OUT = (MIXW / 64) * (DM / 32), I_UP = (DM / 64) * (FF / 32), I_DN = (FF / 64) * (DM / 32), I_G = 2 * 16 * 2;
    constexpr int NITEMS = I_IN + I_OUT + I_UP + I_DN + I_G;
    for (int it = gw; it < NITEMS; it += NGW) {
        int r = it;
        if (r < I_IN) { p0_transpose_item(A.in[2], DM, INW, (bf16*)(ws + WS_WIN), nullptr, scr, r, lane); continue; } r -= I_IN;
        if (r < I_OUT) { const int kb = r / (DM / 32); const float* g = (kb < 16) ? A.in[11] : (A.in[12] - 1024);
            p0_transpose_item(A.in[13], MIXW, DM, (bf16*)(ws + WS_WOUT), g, scr, r, lane); continue; } r -= I_OUT;
        if (r < I_UP) { p0_transpose_item(A.in[15], DM, FF, (bf16*)(ws + WS_WUP), A.in[14], scr, r, lane); continue; } r -= I_UP;
        if (r < I_DN) { p0_transpose_item(A.in[16], FF, DM, (bf16*)(ws + WS_WDN), nullptr, scr, r, lane); continue; } r -= I_DN;
        { const int gate = r / 32, n = (r % 32) / 2, sub = r % 2;
          p0_transpose_item(A.in[gate ? 7 : 5] + n * 4096, 64, 64, (bf16*)(ws + WS_WG) + gate * 65536 + n * 4096, nullptr, scr, sub, lane); }
    }
    const f32x4* gp = (const f32x4*)A.in[1] + lane;
    for (int m = gw; m < M; m += NGW) {
        const f32x4* xr = (const f32x4*)(A.in[0] + (size_t)m * DM) + lane;
        f32x4 v[4]; float s = 0.f;
#pragma unroll
        for (int j = 0; j < 4; ++j) { v[j] = xr[64 * j]; s += (v[j].x * v[j].x + v[j].y * v[j].y) + (v[j].z * v[j].z + v[j].w * v[j].w); }
        const float rs = 1.0f / sqrtf(wave_sum(s) * (1.f / DM) + 1e-6f);
        unsigned long long* o8 = (unsigned long long*)((bf16*)(ws + WS_HN) + (size_t)m * DM) + lane;
#pragma unroll
        for (int j = 0; j < 4; ++j) { const f32x4 g = gp[64 * j]; o8[64 * j] = (unsigned long long)pk2(v[j].x * rs * g.x, v[j].y * rs * g.y) | ((unsigned long long)pk2(v[j].z * rs * g.z, v[j].w * rs * g.w) << 32); }
    }
}

__device__ __forceinline__ int crow(int r, int hi) { return (r & 3) + 8 * (r >> 2) + 4 * hi; }
__device__ __forceinline__ void attn_unit(LAS unsigned char* lds, int b, int j, int kvh, const bf16* proj, const float* sinks, bf16* mixed, float* ssq_attn) {
    const int tid = threadIdx.x, lane = tid & 63, wave = tid >> 6, r32 = lane & 31, hi = lane >> 5;
    constexpr int VROW = 264;
    LAS unsigned char* Kl = lds;
    LAS unsigned short* Vt = (LAS unsigned short*)(lds + 32768);
    const size_t rowb = (size_t)b * SEQ; const int tok0 = (j - 1) * 128;
    __syncthreads();
#pragma unroll
    for (int it = 0; it < 4; ++it) { const int idx = tid + it * 512, key = idx >> 3, c = idx & 7, tok = tok0 + key;
        v4u kv = (v4u){0u, 0u, 0u, 0u}, vv = (v4u){0u, 0u, 0u, 0u};
        if (tok >= 0) { const bf16* p = proj + (rowb + tok) * INW + OFF_K + kvh * 64 + c * 8; kv = *(const v4u*)p; vv = *(const v4u*)(p + 128); }
        *(LAS v4u*)(Kl + c * 4096 + key * 16) = kv;
        LAS unsigned short* vp = Vt + (c * 8) * VROW + key;
        vp[0 * VROW] = (unsigned short)(vv.x & 0xffffu); vp[1 * VROW] = (unsigned short)(vv.x >> 16);
        vp[2 * VROW] = (unsigned short)(vv.y & 0xffffu); vp[3 * VROW] = (unsigned short)(vv.y >> 16);
        vp[4 * VROW] = (unsigned short)(vv.z & 0xffffu); vp[5 * VROW] = (unsigned short)(vv.z >> 16);
        vp[6 * VROW] = (unsigned short)(vv.w & 0xffffu); vp[7 * VROW] = (unsigned short)(vv.w >> 16); }
    __syncthreads();
    const int head = kvh * 8 + wave;
    const float sink2 = sinks[head] * LOG2E;
#pragma unroll 1
    for (int s = 0; s < 4; ++s) {
        const size_t qrow = rowb + j * 128 + 32 * s + r32;
        bf16x8 qf[4];
#pragma unroll
        for (int ks = 0; ks < 4; ++ks) qf[ks] = *(const bf16x8*)(proj + qrow * INW + OFF_Q + head * 64 + 16 * ks + 8 * hi);
        f32x16 S[5];
#pragma unroll
        for (int t5 = 0; t5 < 5; ++t5) { const int kt = s + t5; f32x16 a = {};
#pragma unroll
            for (int ks = 0; ks < 4; ++ks) { const bf16x8 kf = *(const LAS bf16x8*)(Kl + (2 * ks + hi) * 4096 + (32 * kt + r32) * 16); a = __builtin_amdgcn_mfma_f32_32x32x16_bf16(kf, qf[ks], a, 0, 0, 0); }
            S[t5] = a; }
        const int qi = 32 * s + r32; const int jkmin = (j == 0) ? 128 : 0;
        float mx = -1e30f;
#pragma unroll
        for (int t5 = 0; t5 < 5; ++t5)
#pragma unroll
            for (int r = 0; r < 16; ++r) { const int jk = 32 * (s + t5) + crow(r, hi); const int dq = jk - qi; const bool ok = (dq >= 1) && (dq <= 128) && (jk >= jkmin);
                const float v = ok ? S[t5][r] : -1e30f; S[t5][r] = v; mx = fmaxf(mx, v); }
        mx = fmaxf(mx, __shfl_xor(mx, 32)); mx = fmaxf(mx, sink2);
        float l = 0.f;
#pragma unroll
        for (int t5 = 0; t5 < 5; ++t5)
#pragma unroll
            for (int r = 0; r < 16; ++r) { const float p = __builtin_amdgcn_exp2f(S[t5][r] - mx); S[t5][r] = p; l += p; }
        l += __shfl_xor(l, 32); l += __builtin_amdgcn_exp2f(sink2 - mx);
        f32x16 O[2]; O[0] = (f32x16){}; O[1] = (f32x16){};
#pragma unroll
        for (int t5 = 0; t5 < 5; ++t5)
#pragma unroll
            for (int k2 = 0; k2 < 2; ++k2) { const int kb = 32 * (s + t5) + 16 * k2 + 4 * hi;
                v4u pw; pw.x = pk2(S[t5][8 * k2 + 0], S[t5][8 * k2 + 1]); pw.y = pk2(S[t5][8 * k2 + 2], S[t5][8 * k2 + 3]); pw.z = pk2(S[t5][8 * k2 + 4], S[t5][8 * k2 + 5]); pw.w = pk2(S[t5][8 * k2 + 6], S[t5][8 * k2 + 7]);
                const bf16x8 pb = __builtin_bit_cast(bf16x8, pw);
#pragma unroll
                for (int dt = 0; dt < 2; ++dt) { const LAS unsigned short* vr = Vt + (32 * dt + r32) * VROW + kb;
                    const v2u lo = *(const LAS v2u*)vr, hh = *(const LAS v2u*)(vr + 8);
                    const v4u vw = (v4u){lo.x, lo.y, hh.x, hh.y};
                    O[dt] = __builtin_amdgcn_mfma_f32_32x32x16_bf16(__builtin_bit_cast(bf16x8, vw), pb, O[dt], 0, 0, 0); } }
        const float inv = 1.0f / l; float sq = 0.f;
        bf16* orow = mixed + qrow * MIXW + 1024 + head * 64;
#pragma unroll
        for (int dt = 0; dt < 2; ++dt)
#pragma unroll
            for (int g4 = 0; g4 < 4; ++g4) { const float o0 = O[dt][4 * g4] * inv, o1 = O[dt][4 * g4 + 1] * inv, o2 = O[dt][4 * g4 + 2] * inv, o3 = O[dt][4 * g4 + 3] * inv;
                sq += (o0 * o0 + o1 * o1) + (o2 * o2 + o3 * o3);
                v2u w; w.x = pk2(o0, o1); w.y = pk2(o2, o3); *(v2u*)(orow + 32 * dt + 8 * g4 + 4 * hi) = w; }
        sq += __shfl_xor(sq, 32);
        if (hi == 0) ssq_attn[qrow * 16 + head] = sq;
    }
}

__device__ __forceinline__ float sigm(float z) { return __builtin_amdgcn_rcpf(1.0f + __builtin_amdgcn_exp2f(-z * LOG2E)); }
__device__ __forceinline__ void lru_load_x(bf16x8 (&xr)[2][4], const bf16* xcol, size_t rowb, int t) {
#pragma unroll
    for (int tap = 0; tap < 4; ++tap) { const int tt = t - 3 + tap;
#pragma unroll
        for (int ks = 0; ks < 2; ++ks) { bf16x8 v = (bf16x8){0, 0, 0, 0, 0, 0, 0, 0}; if (tt >= 0) v = *(const bf16x8*)(xcol + (rowb + tt) * INW + 32 * ks); xr[ks][tap] = v; } }
}
__device__ __forceinline__ void lru_unit(LAS unsigned char* lds, int b, int n, int half, const bf16* proj, const bf16* WgA, const bf16* WgX, const float* conv_w, const float* conv_b,
                                         const float* b_a, const float* b_x, const float* lam, bf16* mixed, float* ssq_lru) {
    const int tid = threadIdx.x, lane = tid & 63, wave = tid >> 6, fr = lane & 15, fq = lane >> 4;
    LAS float* cwl = (LAS float*)lds;
    LAS float* exch = (LAS float*)(lds + 2048);
    LAS float* xcs = (LAS float*)(lds + 8192) + wave * (16 * 36);
    __syncthreads();
    if (tid < 320) { const int tap = tid >> 6, c = tid & 63; cwl[tid] = tap < 4 ? conv_w[tap * 1024 + n * 64 + c] : conv_b[n * 64 + c]; }
    __syncthreads();
    bf16x8 wa[2][2], wx[2][2]; float ba[2], bx[2], c1[2], hc[2];
#pragma unroll
    for (int nt = 0; nt < 2; ++nt) { const int dl = 32 * half + 16 * nt + fr, ch = n * 64 + dl;
#pragma unroll
        for (int ks = 0; ks < 2; ++ks) { const size_t idx = (size_t)(n * 64 + dl) * 64 + 32 * ks + 8 * fq; wa[nt][ks] = *(const bf16x8*)(WgA + idx); wx[nt][ks] = *(const bf16x8*)(WgX + idx); }
        ba[nt] = b_a[ch]; bx[nt] = b_x[ch]; const float L = lam[ch];
        const float sp = (L < -20.f) ? -L : log1pf(expf(-L));
        c1[nt] = -8.0f * sp * LOG2E; hc[nt] = 0.f; }
    const size_t rowb = (size_t)b * SEQ;
    const bf16* xcol = proj + n * 64 + 8 * fq;
    bf16x8 xcur[2][4];
    lru_load_x(xcur, xcol, rowb, wave * 16 + fr);
#pragma unroll 1
    for (int chunk = 0; chunk < 16; ++chunk) {
        const int tb = chunk * 128 + wave * 16;
        bf16x8 xnext[2][4];
        { const int cn = chunk < 15 ? chunk + 1 : 15; lru_load_x(xnext, xcol, rowb, cn * 128 + wave * 16 + fr); }
        unsigned short gv[2][4];
#pragma unroll
        for (int nt = 0; nt < 2; ++nt)
#pragma unroll
            for (int i = 0; i < 4; ++i) gv[nt][i] = proj[(rowb + tb + 4 * fq + i) * INW + OFF_G + n * 64 + 32 * half + 16 * nt + fr];
        float xc[2][8];
#pragma unroll
        for (int ks = 0; ks < 2; ++ks) {
            const f32x4 b0 = *(const LAS f32x4*)(cwl + 256 + 32 * ks + 8 * fq), b1 = *(const LAS f32x4*)(cwl + 256 + 32 * ks + 8 * fq + 4);
#pragma unroll
            for (int e = 0; e < 4; ++e) { xc[ks][e] = b0[e]; xc[ks][4 + e] = b1[e]; }
#pragma unroll
            for (int tap = 0; tap < 4; ++tap) { const f32x4 w0 = *(const LAS f32x4*)(cwl + tap * 64 + 32 * ks + 8 * fq), w1 = *(const LAS f32x4*)(cwl + tap * 64 + 32 * ks + 8 * fq + 4);
#pragma unroll
                for (int e = 0; e < 4; ++e) { xc[ks][e] += w0[e] * bf2f((unsigned short)xcur[ks][tap][e]); xc[ks][4 + e] += w1[e] * bf2f((unsigned short)xcur[ks][tap][4 + e]); } } }
        bf16x8 af[2];
#pragma unroll
        for (int ks = 0; ks < 2; ++ks) { v4u w; w.x = pk2(xc[ks][0], xc[ks][1]); w.y = pk2(xc[ks][2], xc[ks][3]); w.z = pk2(xc[ks][4], xc[ks][5]); w.w = pk2(xc[ks][6], xc[ks][7]); af[ks] = __builtin_bit_cast(bf16x8, w); }
        f32x4 ra[2], ia[2];
#pragma unroll
        for (int nt = 0; nt < 2; ++nt) { ra[nt] = (f32x4){0.f, 0.f, 0.f, 0.f}; ia[nt] = (f32x4){0.f, 0.f, 0.f, 0.f};
#pragma unroll
            for (int ks = 0; ks < 2; ++ks) { ra[nt] = __builtin_amdgcn_mfma_f32_16x16x32_bf16(af[ks], wa[nt][ks], ra[nt], 0, 0, 0); ia[nt] = __builtin_amdgcn_mfma_f32_16x16x32_bf16(af[ks], wx[nt][ks], ia[nt], 0, 0, 0); } }
        { const int ks = half; LAS float* wp = xcs + fr * 36 + 8 * fq;
          *(LAS f32x4*)wp = (f32x4){xc[ks][0], xc[ks][1], xc[ks][2], xc[ks][3]}; *(LAS f32x4*)(wp + 4) = (f32x4){xc[ks][4], xc[ks][5], xc[ks][6], xc[ks][7]}; }
        __builtin_amdgcn_wave_barrier(); asm volatile("s_waitcnt lgkmcnt(0)" ::: "memory");
        float Al[2][4], Hl[2][4], Ai[2], Hi[2];
#pragma unroll
        for (int nt = 0; nt < 2; ++nt) { float a_run = 1.f, h_run = 0.f;
#pragma unroll
            for (int i = 0; i < 4; ++i) { const float xv = xcs[(4 * fq + i) * 36 + 16 * nt + fr];
                const float r = sigm(ra[nt][i] + ba[nt]), ig = sigm(ia[nt][i] + bx[nt]);
                const float la2 = c1[nt] * r, a = __builtin_amdgcn_exp2f(la2);
                const float x2 = la2 * (2.0f * 0.6931471805599453f);
                const float em = (x2 > -0.03f) ? -x2 * (1.0f + x2 * (0.5f + x2 * (0.16666667f + x2 * 0.041666668f))) : 1.0f - a * a;
                const float bt = __builtin_amdgcn_sqrtf(em) * (ig * xv);
                h_run = a * h_run + bt; a_run *= a; Al[nt][i] = a_run; Hl[nt][i] = h_run; }
            float A = a_run, H = h_run;
            { const float Ap = __shfl_up(A, 16), Hp = __shfl_up(H, 16); if (fq >= 1) { H = A * Hp + H; A = A * Ap; } }
            { const float Ap = __shfl_up(A, 32), Hp = __shfl_up(H, 32); if (fq >= 2) { H = A * Hp + H; A = A * Ap; } }
            Ai[nt] = A; Hi[nt] = H; }
        __builtin_amdgcn_wave_barrier();
        const int buf = chunk & 1;
        if (fq == 3) {
#pragma unroll
            for (int nt = 0; nt < 2; ++nt) { LAS float* e = exch + ((buf * 8 + wave) * 32 + nt * 16 + fr) * 2; e[0] = Ai[nt]; e[1] = Hi[nt]; } }
        __syncthreads();
        float sq[4] = {0.f, 0.f, 0.f, 0.f}; float yv[2][4];
#pragma unroll
        for (int nt = 0; nt < 2; ++nt) {
            float hw = hc[nt], hin_w = 0.f;
#pragma unroll
            for (int w = 0; w < 8; ++w) { const LAS float* e = exch + ((buf * 8 + w) * 32 + nt * 16 + fr) * 2; const float Aw = e[0], Hw = e[1]; if (w == wave) hin_w = hw; hw = Aw * hw + Hw; }
            hc[nt] = hw;
            float Aex = __shfl_up(Ai[nt], 16), Hex = __shfl_up(Hi[nt], 16); if (fq == 0) { Aex = 1.f; Hex = 0.f; }
            const float hin = Aex * hin_w + Hex;
#pragma unroll
            for (int i = 0; i < 4; ++i) { const float h = Hl[nt][i] + Al[nt][i] * hin; const float g = bf2f(gv[nt][i]);
                const float u2 = 1.5957691216057308f * (g + 0.044715f * g * g * g);
                const float y = h * g * sigm(u2); yv[nt][i] = y; sq[i] += y * y; } }
#pragma unroll
        for (int i = 0; i < 4; ++i) { float s = sq[i]; s += __shfl_xor(s, 1); s += __shfl_xor(s, 2); s += __shfl_xor(s, 4); s += __shfl_xor(s, 8);
            const size_t row = rowb + tb + 4 * fq + i;
            if (fr == 0) ssq_lru[row * 32 + n * 2 + half] = s;
#pragma unroll
            for (int nt = 0; nt < 2; ++nt) { bf16 hb = (bf16)(pk2(yv[nt][i], 0.f) & 0xffffu); mixed[row * MIXW + n * 64 + 32 * half + 16 * nt + fr] = hb; } }
#pragma unroll
        for (int ks = 0; ks < 2; ++ks)
#pragma unroll
            for (int tap = 0; tap < 4; ++tap) xcur[ks][tap] = xnext[ks][tap];
    }
}

#define XB_TMO      128
#define XB_XCNT(j)  (256  + 64 * (j))
#define XB_XSUB(j)  (1280 + 64 * (j))
#define XB_XGEN(j)  (2304 + 64 * (j))
#define XB_TOP      3328
#define XB_TOPGEN   3392
#define XCD_BAR_WORDS 3456
#define XB_SPIN_CAP (1u << 18)

__device__ __forceinline__ unsigned xb_ld(unsigned* p)              { return __hip_atomic_load(p, __ATOMIC_RELAXED, __HIP_MEMORY_SCOPE_AGENT); }
__device__ __forceinline__ unsigned xb_add(unsigned* p, unsigned v) { return __hip_atomic_fetch_add(p, v, __ATOMIC_RELAXED, __HIP_MEMORY_SCOPE_AGENT); }
__device__ __forceinline__ unsigned xb_xcc_id() { return (unsigned)__builtin_amdgcn_s_getreg((3 << 11) | 20) & 0xFu; }
#define XB_SPIN(cond, bar) do { unsigned _sp = 0; while (cond) { __builtin_amdgcn_s_sleep(1); \
    if ((++_sp & 255u) == 0u) { if (xb_ld(&(bar)[XB_TMO])) break; if (_sp > XB_SPIN_CAP) { atomicAdd(&(bar)[XB_TMO], 1u); break; } } } } while (0)

struct XcdBarrier {
    unsigned* bar; unsigned x;
    volatile LAS unsigned* st;
};

__device__ __forceinline__ XcdBarrier xcd_barrier_post(unsigned* bar, volatile LAS unsigned* st) {
    XcdBarrier b; b.bar = bar; b.x = xb_xcc_id(); b.st = st;
    if (threadIdx.x == 0) (void)xb_add(&bar[XB_XCNT(b.x)], 1u);
    return b;
}
__device__ __forceinline__ void xcd_barrier_complete(unsigned* bar, unsigned x, unsigned& nloc, unsigned& nx) {
    const unsigned G = gridDim.x * gridDim.y * gridDim.z;
    unsigned sum, cnt, mine, sp = 0u;
    for (;;) {
        sum = 0u; cnt = 0u; mine = 0u;
#pragma unroll
        for (unsigned j = 0; j < 16; ++j) { const unsigned c = xb_ld(&bar[XB_XCNT(j)]); sum += c; cnt += (c > 0u) ? 1u : 0u; mine = (j == x) ? c : mine; }
        if (sum == G) break;
        __builtin_amdgcn_s_sleep(1);
        if ((++sp & 255u) == 0u) { if (xb_ld(&bar[XB_TMO])) break; if (sp > XB_SPIN_CAP) { atomicAdd(&bar[XB_TMO], 1u); break; } }
    }
    nloc = mine > 0u ? mine : 1u; nx = cnt > 0u ? cnt : 1u;
}

__device__ __forceinline__ void xcd_barrier(const XcdBarrier& b) {
    asm volatile("s_waitcnt vmcnt(0)" ::: "memory");
    __syncthreads();
    if (threadIdx.x == 0) {
        unsigned* bar = b.bar;
        __builtin_amdgcn_s_waitcnt(0);
        unsigned nloc = b.st[0], nx = b.st[1];
        if (nloc == 0u) { xcd_barrier_complete(bar, b.x, nloc, nx); b.st[0] = nloc; b.st[1] = nx; }
        const unsigned old = xb_add(&bar[XB_XSUB(b.x)], 1u);
        const unsigned gen = old / nloc;
        if (old + 1u == (gen + 1u) * nloc) {
            __builtin_amdgcn_fence(__ATOMIC_RELEASE, "agent");
            asm volatile("s_waitcnt vmcnt(0)" ::: "memory");
            const unsigned og = xb_add(&bar[XB_TOP], 1u);
            const unsigned tg = og / nx;
            if (og + 1u == (tg + 1u) * nx) xb_add(&bar[XB_TOPGEN], 1u);
            else XB_SPIN(xb_ld(&bar[XB_TOPGEN]) == tg, bar);
            __builtin_amdgcn_fence(__ATOMIC_ACQUIRE, "agent");
            xb_add(&bar[XB_XGEN(b.x)], 1u);
            asm volatile("s_waitcnt vmcnt(0)" ::: "memory");
        } else {
            XB_SPIN(xb_ld(&bar[XB_XGEN(b.x)]) == gen, bar);
            __builtin_amdgcn_fence(__ATOMIC_ACQUIRE, "agent");
            asm volatile("s_waitcnt vmcnt(0)" ::: "memory");
        }
    }
    __syncthreads();
}

__global__ void __launch_bounds__(NWAVES * 64, 2) fwd_megakernel(Args args) {
    extern __shared__ __attribute__((aligned(16))) unsigned char lds_raw[];
    LAS unsigned char* lds = (LAS unsigned char*)lds_raw;
    cg::grid_group grid = cg::this_grid();
    const int tid = threadIdx.x, lane = tid & 63, wave = __builtin_amdgcn_readfirstlane(tid >> 6);
    const int G = gridDim.x, bx = blockIdx.x, vcu = (G % 8 == 0) ? (bx % 8) * (G / 8) + bx / 8 : bx;
    unsigned char* ws = args.ws;
    bf16* HN = (bf16*)(ws + WS_HN); bf16* PROJ = (bf16*)(ws + WS_PROJ); bf16* MIX = (bf16*)(ws + WS_MIX); bf16* HB = (bf16*)(ws + WS_H);
    float* SSQ_LRU = (float*)(ws + WS_SSQ_LRU); float* SSQ_ATT = (float*)(ws + WS_SSQ_ATT); float* SSQ_X1 = (float*)(ws + WS_SSQ_X1); float* SSQ_X2 = (float*)(ws + WS_SSQ_X2);

    unsigned* barw = (unsigned*)ws;
    volatile LAS unsigned* bst = (volatile LAS unsigned*)(lds + 140000);
    if (tid == 0) { bst[0] = 0u; bst[1] = 0u; }
    __syncthreads();
    if (args.ws == nullptr) grid.sync();
    const XcdBarrier xbar = xcd_barrier_post(barw, bst);
    p0_prologue(args, lds, vcu, G, wave, lane);
    xcd_barrier(xbar);

    { pg8::Gemm g{HN, (const bf16*)(ws + WS_WIN), M, INW, DM}; pg8::StaticOrder S; S.init(M, INW, G, bx);
      pg8::EpiProj E{PROJ, INW, QSCALE};
      pg8::gemm_phase<pg8::EpiProj, pg8::StaticOrder, true, true>(lds, g, S, E); }
    xcd_barrier(xbar);

    for (int u = vcu; u < 256; u += G) attn_unit(lds, u >> 5, (u >> 1) & 15, u & 1, PROJ, args.in[10], MIX, SSQ_ATT);
    for (int u = vcu; u < 256; u += G) lru_unit(lds, u >> 5, (u >> 1) & 15, u & 1, PROJ, (const bf16*)(ws + WS_WG), (const bf16*)(ws + WS_WG) + 65536, args.in[3], args.in[4], args.in[6], args.in[8], args.in[9], MIX, SSQ_LRU);
    xcd_barrier(xbar);

    { pg8::Gemm g{MIX, (const bf16*)(ws + WS_WOUT), M, DM, MIXW}; pg8::StaticOrder S; S.init(M, DM, G, bx);
      LAS float* ratio = (LAS float*)(lds + TAB_OFF); LAS float* rsl = ratio + 256;
      pg8::Unit u0; const bool has = S.next(0, u0);
      __syncthreads();
      if (has && tid < 256) { const size_t row = (size_t)u0.pm * 256 + tid; float sl = 0.f, sa = 0.f;
          const f32x4* pl = (const f32x4*)(SSQ_LRU + row * 32); const f32x4* pa = (const f32x4*)(SSQ_ATT + row * 16);
#pragma unroll
          for (int i = 0; i < 8; ++i) { const f32x4 v = pl[i]; sl += (v[0] + v[1]) + (v[2] + v[3]); }
#pragma unroll
          for (int i = 0; i < 4; ++i) { const f32x4 v = pa[i]; sa += (v[0] + v[1]) + (v[2] + v[3]); }
          const float rl = 1.0f / sqrtf(sl * (1.f / 1024.f) + 1e-6f), ra = 1.0f / sqrtf(sa * (1.f / 1024.f) + 1e-6f);
          ratio[tid] = rl / ra; rsl[tid] = ra; }
      __syncthreads();
      typedef pg8::EpiRes<true, true> EO;
      EO E{args.in[0], args.out, HN, SSQ_X1, ratio, rsl};
      pg8::gemm_phase<EO, pg8::StaticOrder, false, true>(lds, g, S, E); }
    xcd_barrier(xbar);

    { pg8::Gemm g{HN, (const bf16*)(ws + WS_WUP), M, FF, DM}; pg8::StaticOrder S; S.init(M, FF, G, bx);
      pg8::EpiUp E{HB, FF, SSQ_X1};
      pg8::gemm_phase<pg8::EpiUp, pg8::StaticOrder, true, true>(lds, g, S, E); }
    xcd_barrier(xbar);

    { pg8::Gemm g{HB, (const bf16*)(ws + WS_WDN), M, DM, FF}; pg8::StaticOrder S; S.init(M, DM, G, bx);
      typedef pg8::EpiRes<false, false> ED;
      ED E{args.out, args.out, nullptr, SSQ_X2, nullptr, nullptr};
      pg8::gemm_phase<ED, pg8::StaticOrder, false, true>(lds, g, S, E); }
    xcd_barrier(xbar);

    { const int gw = vcu * NWAVES + wave, NGW = G * NWAVES; const f32x4* gp = (const f32x4*)args.in[17] + lane;
      for (int m = gw; m < M; m += NGW) { const f32x4 p = *(const f32x4*)(SSQ_X2 + (size_t)m * 4);
          const float rs = 1.0f / sqrtf(((p[0] + p[1]) + (p[2] + p[3])) * (1.f / DM) + 1e-6f);
          f32x4* xr = (f32x4*)(args.out + (size_t)m * DM) + lane;
#pragma unroll
          for (int j = 0; j < 4; ++j) { const f32x4 v = xr[64 * j], g4 = gp[64 * j]; xr[64 * j] = v * rs * g4; } } }
}

extern "C" void kernel_launch(void* const* d_in, const int* in_sizes, int n_in, void* d_out, int out_size, void* d_ws, size_t ws_size, hipStream_t stream) {
    static int grid = 0;
    if (grid == 0) {
        int dev = 0, cus = 0, per_cu = 0;
        (void)hipGetDevice(&dev); (void)hipDeviceGetAttribute(&cus, hipDeviceAttributeMultiprocessorCount, dev);
        if (hipFuncSetAttribute((const void*)fwd_megakernel, hipFuncAttributeMaxDynamicSharedMemorySize, LDS_BYTES) != hipSuccess) fprintf(stderr, "kernel_launch: hipFuncSetAttribute failed\n");
        if (hipOccupancyMaxActiveBlocksPerMultiprocessor(&per_cu, (const void*)fwd_megakernel, NWAVES * 64, LDS_BYTES) != hipSuccess || per_cu < 1) per_cu = 1;
        (void)hipGetLastError();
        grid = cus * per_cu; if (grid > 256) grid = 256; if (grid < 1) grid = 256;
        if (n_in != 18 || ws_size < WS_END) fprintf(stderr, "kernel_launch: unexpected n_in %d / ws %zu\n", n_in, ws_size);
    }
    (void)hipMemsetAsync(d_ws, 0, 65536, stream);
    Args a{};
    for (int i = 0; i < 18; ++i) a.in[i] = (const float*)d_in[i];
    a.out = (float*)d_out; a.ws = (unsigned char*)d_ws;
    void* kargs[] = {&a};
    hipError_t e = hipLaunchCooperativeKernel((const void*)fwd_megakernel, dim3(grid), dim3(NWAVES * 64), kargs, LDS_BYTES, stream);
    if (e != hipSuccess) fprintf(stderr, "cooperative launch failed: %s (grid %d)\n", hipGetErrorString(e), grid);
}
```
